# Optimizing an MI355X kernel written in HIP

```python
import math
import jax, jax.numpy as jnp
from jax import lax
import numpy as np

D_MODEL = 4096
BATCH = 1
SEQ = 16384
DEPTH = 2

N_A_LAYERS = DEPTH - DEPTH // 2
N_B_LAYERS = DEPTH // 2
CONV_WIDTH = 3
CONV_DIM = D_MODEL
HEAD_DIM = 64
N_HEADS = D_MODEL // HEAD_DIM
N_KV_HEADS = N_HEADS // 8
GROUP = N_HEADS // N_KV_HEADS
ATTN_DIM = N_HEADS * HEAD_DIM
KV_DIM = N_KV_HEADS * HEAD_DIM
WINDOW = 128
BLOCK = 128
N_BUCKETS = 32
MAX_DISTANCE = 128
EPS = 1e-6

kernel_name = "yoco_shortconv_swa_sink_hybrid"


def rmsnorm(x, g):
    x32 = x.astype(jnp.float32)
    y = x32 * lax.rsqrt(jnp.mean(x32 * x32, axis=-1, keepdims=True) + EPS)
    return (y * g.astype(jnp.float32)).astype(x.dtype)


def modulated_rmsnorm(x, g, shift, scale):
    return rmsnorm(x, g) * (1 + scale[:, None, :]) + shift[:, None, :]


def adaln_params(c_act, w_mod, b_mod, n_chunks):
    mod = c_act @ w_mod + b_mod
    return jnp.split(mod, n_chunks, axis=-1)


def causal_short_conv(u, w):
    s_ = u.shape[1]
    up = jnp.pad(u, ((0, 0), (CONV_WIDTH - 1, 0), (0, 0)))
    y = w[0] * up[:, 0:s_]
    for k in range(1, CONV_WIDTH):
        y = y + w[k] * up[:, k:k + s_]
    return y


def short_conv_mixer(h, w_in, conv_w, w_out):
    proj = h @ w_in
    b_gate, c_gate, u, z = jnp.split(proj, 4, axis=-1)
    y = b_gate * causal_short_conv(c_gate * u, conv_w)
    return (y * jax.nn.silu(z)) @ w_out


def t5_bucket(dist):
    max_exact = N_BUCKETS // 2
    d = jnp.maximum(dist, 0)
    d_f = jnp.maximum(d, 1).astype(jnp.float32)
    large = max_exact + (jnp.log(d_f / max_exact) / math.log(MAX_DISTANCE / max_exact)
                         * (N_BUCKETS - max_exact)).astype(jnp.int32)
    large = jnp.minimum(large, N_BUCKETS - 1)
    return jnp.where(d < max_exact, d, large)


def band_geometry(rel_bias):
    a = jnp.arange(BLOCK)[:, None]
    b = jnp.arange(2 * BLOCK)[None, :]
    dist = a + BLOCK - b
    band = (dist >= 0) & (dist < WINDOW)
    bias = rel_bias[t5_bucket(dist)]
    bias = bias.transpose(2, 0, 1).reshape(N_KV_HEADS, GROUP, BLOCK, 2 * BLOCK)
    return band, bias.astype(jnp.float32)


def sliding_window_attention(q, k, v, band, bias, sink):
    b_, s_ = q.shape[:2]
    nb = s_ // BLOCK
    qb = q.reshape(b_, nb, BLOCK, N_KV_HEADS, GROUP, HEAD_DIM).transpose(1, 0, 2, 3, 4, 5)

    def windows(t):
        tb = t.reshape(b_, nb, BLOCK, N_KV_HEADS, HEAD_DIM)
        prev = jnp.concatenate([jnp.zeros_like(tb[:, :1]), tb[:, :-1]], axis=1)
        return jnp.concatenate([prev, tb], axis=2).transpose(1, 0, 2, 3, 4)

    kw, vw = windows(k), windows(v)
    key_off = jnp.arange(2 * BLOCK) - BLOCK
    sink_l = sink.astype(jnp.float32).reshape(N_KV_HEADS, GROUP, 1, 1)

    def one_block(args):
        qi, ki, vi, blk = args
        logits = jnp.einsum('bqhgd,bkhd->bhgqk', qi, ki).astype(jnp.float32) + bias
        valid = band & ((blk * BLOCK + key_off) >= 0)[None, :]
        logits = jnp.where(valid, logits, -jnp.inf)
        m = jnp.maximum(jnp.max(logits, axis=-1, keepdims=True), sink_l)
        p = jnp.exp(logits - m)
        denom = jnp.sum(p, axis=-1, keepdims=True) + jnp.exp(sink_l - m)
        out = jnp.einsum('bhgqk,bkhd->bqhgd', p / denom, vi.astype(jnp.float32))
        return out.astype(qi.dtype)

    out = lax.map(one_block, (qb, kw, vw, jnp.arange(nb)))
    return out.transpose(1, 0, 2, 3, 4, 5).reshape(b_, s_, ATTN_DIM)


def setup_inputs(seed: int = 0) -> dict:
    key = jax.random.key(seed)
    ks = jax.random.split(key, 24)
    D = D_MODEL
    f = jnp.float32
    nrm = lambda k, shape, std: (jax.random.normal(k, shape, f) * std).astype(f)
    mod_std = 0.2 * D ** -0.5
    return {
        "x": nrm(ks[0], (BATCH, SEQ, D), 1.0),
        "c": nrm(ks[1], (BATCH, D), 1.0),
        "g_a": 1.0 + nrm(ks[2], (N_A_LAYERS, D), 0.05),
        "w_mod_a": nrm(ks[3], (N_A_LAYERS, D, 3 * D), mod_std),
        "b_mod_a": nrm(ks[4], (N_A_LAYERS, 3 * D), 0.05),
        "w_a_in": nrm(ks[5], (N_A_LAYERS, D, 4 * CONV_DIM), D ** -0.5),
        "conv_a": nrm(ks[6], (N_A_LAYERS, CONV_WIDTH, CONV_DIM), CONV_WIDTH ** -0.5),
        "w_a_out": nrm(ks[7], (N_A_LAYERS, CONV_DIM, D), CONV_DIM ** -0.5),
        "g_kv": 1.0 + nrm(ks[8], (D,), 0.05),
        "w_mod_kv": nrm(ks[9], (D, 2 * D), mod_std),
        "b_mod_kv": nrm(ks[10], (2 * D,), 0.05),
        "w_kv": nrm(ks[11], (D, 2 * KV_DIM), D ** -0.5),
        "rel_bias": nrm(ks[12], (N_BUCKETS, N_HEADS), 0.5),
        "g_b": 1.0 + nrm(ks[13], (N_B_LAYERS, D), 0.05),
        "w_mod_b": nrm(ks[14], (N_B_LAYERS, D, 3 * D), mod_std),
        "b_mod_b": nrm(ks[15], (N_B_LAYERS, 3 * D), 0.05),
        "w_b_in": nrm(ks[16], (N_B_LAYERS, D, 2 * ATTN_DIM), D ** -0.5),
        "sinks_b": nrm(ks[17], (N_B_LAYERS, N_HEADS), 1.0),
        "w_b_out": nrm(ks[18], (N_B_LAYERS, ATTN_DIM, D), ATTN_DIM ** -0.5),
        "g_final": 1.0 + nrm(ks[19], (D,), 0.05),
    }


def reference(x, c, g_a, w_mod_a, b_mod_a, w_a_in, conv_a, w_a_out, g_kv, w_mod_kv, b_mod_kv,
              w_kv, rel_bias, g_b, w_mod_b, b_mod_b, w_b_in, sinks_b, w_b_out, g_final):
    b_, s_ = x.shape[:2]
    c_act = jax.nn.silu(c)
    band, bias = band_geometry(rel_bias)
    k = None
    v = None
    for layer in range(DEPTH):
        if layer < N_A_LAYERS:
            i = layer
            shift, scale, gate = adaln_params(c_act, w_mod_a[i], b_mod_a[i], 3)
            h = modulated_rmsnorm(x, g_a[i], shift, scale)
            x = x + gate[:, None, :] * short_conv_mixer(h, w_a_in[i], conv_a[i], w_a_out[i])
        else:
            i = layer - N_A_LAYERS
            if i == 0:
                shift_kv, scale_kv = adaln_params(c_act, w_mod_kv, b_mod_kv, 2)
                h_kv = modulated_rmsnorm(x, g_kv, shift_kv, scale_kv)
                k, v = jnp.split(h_kv @ w_kv, 2, axis=-1)
                k = k.reshape(b_, s_, N_KV_HEADS, HEAD_DIM)
                v = v.reshape(b_, s_, N_KV_HEADS, HEAD_DIM)
            shift, scale, gate = adaln_params(c_act, w_mod_b[i], b_mod_b[i], 3)
            h = modulated_rmsnorm(x, g_b[i], shift, scale)
            q, z = jnp.split(h @ w_b_in[i], 2, axis=-1)
            q = q.reshape(b_, s_, N_HEADS, HEAD_DIM) * (HEAD_DIM ** -0.5)
            attn = sliding_window_attention(q, k, v, band, bias, sinks_b[i])
            x = x + gate[:, None, :] * ((attn * jax.nn.silu(z)) @ w_b_out[i])
    return rmsnorm(x, g_final)
```

```cpp
#include <hip/hip_runtime.h>
#include <cstdio>
#include <cstdint>
namespace pg8 {
#define PG8_LAS __attribute__((address_space(3)))
typedef unsigned short bf16_t;
typedef short bf16x8 __attribute__((ext_vector_type(8)));
typedef float f32x4 __attribute__((ext_vector_type(4)));
typedef unsigned u32x4 __attribute__((ext_vector_type(4)));
constexpr int BM = 256, BK = 64, HALF = 128, HTB = HALF * BK * 2  , STAGE_BYTES = 8 * HTB, NXCD = 8, WGM = 8;

__host__ __device__ __forceinline__ int lds_byte(int r, int c) { const int st = (r >> 4) * 2 + (c >> 5), rr = r & 15, cc = c & 31, ob = rr * 64 + cc * 2; return st * 1024 + (ob ^ (((ob >> 9) & 1) << 5)); }
__host__ __device__ __forceinline__ void stage_rc(int b, int& R, int& C) { const int st = b / 1024, sb = b % 1024, swz = sb ^ (((sb >> 9) & 1) << 5); R = (st >> 1) * 16 + swz / 64; C = (st & 1) * 32 + (swz % 64) / 2; }
__host__ __device__ __forceinline__ int perm32(int rho) { const int n = rho >> 4, i = rho & 15; return 8 * (i >> 2) + 4 * n + (i & 3); }

struct Unit { int pm, pn; };
struct Gemm { const bf16_t* A; const bf16_t* Bt; int M, N, K; };

struct StaticOrder {
    int nM, nN, nwg, G, c;
    __host__ __device__ void init(int M, int N, int G_, int c_) { nM = M / BM; nN = N / BM; nwg = nM * nN; G = G_; c = c_; }
    __host__ __device__ bool next(int i, Unit& u) const {
        const long L = (long)i * G + c; if (L >= nwg) return false;
        int wgid = (int)L; { const int q = nwg / NXCD, r = nwg % NXCD, xcd = wgid % NXCD, off = wgid / NXCD; wgid = (xcd < r ? xcd * (q + 1) : r * (q + 1) + (xcd - r) * q) + off; }
        const int nig = WGM * nN, gid = wgid / nig, fm = gid * WGM, gsz = (nM - fm) < WGM ? (nM - fm) : WGM;
        u.pm = fm + ((wgid % nig) % gsz); u.pn = (wgid % nig) / gsz; return true;
    }
    __device__ __forceinline__ void a_ready(const Unit&) const {}
    __device__ __forceinline__ void done(const Unit&) const {}
};
__device__ __forceinline__ unsigned cvt_pk_bf16(float lo, float hi) { unsigned r; asm volatile("v_cvt_pk_bf16_f32 %0, %1, %2" : "=v"(r) : "v"(lo), "v"(hi)); return r; }
__device__ __forceinline__ float silu_f(float v) { return v * __builtin_amdgcn_rcpf(1.0f + __expf(-v)); }

struct EpiBf16S {
    static constexpr bool PERM = true, AFTER_DRAIN = false;
    bf16_t* O; int ldc; int split_cols; size_t split_stride; float scale0; int silu1;
    __device__ __forceinline__ void operator()(const f32x4 (&acc)[2][2][4][2], const Unit& u, int wr, int wc, int fr, int fq) const {
        const int row0 = u.pm * BM + wr * 64 + fr; int colt = u.pn * BM; bf16_t* base = O;
        float sc = 1.f; bool act = false;
        if (split_cols) { const int t = colt / split_cols; base += (size_t)t * split_stride; colt -= t * split_cols; if (t == 0) sc = scale0; else act = (silu1 != 0); }
        const int col0 = colt + wc * 32 + 8 * fq;
#pragma unroll
        for (int ai = 0; ai < 2; ++ai)
#pragma unroll
            for (int m = 0; m < 4; ++m) { bf16_t* rowp = base + (size_t)(row0 + ai * HALF + m * 16) * ldc + col0;
#pragma unroll
                for (int bj = 0; bj < 2; ++bj) { f32x4 v0 = acc[ai][bj][m][0], v1 = acc[ai][bj][m][1];
                    if (act) { v0 = (f32x4){silu_f(v0[0]), silu_f(v0[1]), silu_f(v0[2]), silu_f(v0[3])}; v1 = (f32x4){silu_f(v1[0]), silu_f(v1[1]), silu_f(v1[2]), silu_f(v1[3])}; }
                    v0 = v0 * sc; v1 = v1 * sc; u32x4 w; w.x = cvt_pk_bf16(v0[0], v0[1]); w.y = cvt_pk_bf16(v0[2], v0[3]); w.z = cvt_pk_bf16(v1[0], v1[1]); w.w = cvt_pk_bf16(v1[2], v1[3]);
                    *(u32x4*)(rowp + bj * HALF) = w; } }
    }
};

struct EpiResGate {
    static constexpr bool PERM = false, AFTER_DRAIN = false;
    const float* base; float* out; int ldc; const float* gate;
    __device__ __forceinline__ void operator()(const f32x4 (&acc)[2][2][4][2], const Unit& u, int wr, int wc, int fr, int fq) const {
        const int col0 = u.pn * BM + wc * 32 + 4 * fq;
        f32x4 gv[2][2];
#pragma unroll
        for (int bj = 0; bj < 2; ++bj)
#pragma unroll
            for (int n = 0; n < 2; ++n) gv[bj][n] = *(const f32x4*)(gate + col0 + bj * HALF + n * 16);
#pragma unroll
        for (int ai = 0; ai < 2; ++ai)
#pragma unroll
            for (int m = 0; m < 4; ++m) { const size_t off = (size_t)(u.pm * BM + ai * HALF + wr * 64 + m * 16 + fr) * ldc + col0;
#pragma unroll
                for (int bj = 0; bj < 2; ++bj)
#pragma unroll
                    for (int n = 0; n < 2; ++n) { const f32x4 bs = *(const f32x4*)(base + off + bj * HALF + n * 16);
                        *(f32x4*)(out + off + bj * HALF + n * 16) = bs + gv[bj][n] * acc[ai][bj][m][n]; }
                if (m & 1) asm volatile("" ::: "memory"); }
    }
};

template <class Epi, class Sched, bool ALIGN_EPI = false, bool SP2 = false>
__device__ __forceinline__ void gemm_phase(PG8_LAS unsigned char* lds, const Gemm g, const Sched& S, const Epi& E) {
    const int tid = threadIdx.x, wid = __builtin_amdgcn_readfirstlane(tid >> 6), lane = tid & 63, wr = wid >> 2, wc = wid & 3, fr = lane & 15, fq = lane >> 4;
    const int K = g.K, nt = K / BK;
    unsigned voffA[2], voffB[2];
#pragma unroll
    for (int i = 0; i < 2; ++i) { int R, C; stage_rc(tid * 16 + i * 8192, R, C); const int Rb = Epi::PERM ? ((R & ~31) + perm32(R & 31)) : R;
        voffA[i] = (unsigned)(R * K + C) * 2u; voffB[i] = (unsigned)(Rb * K + C) * 2u; }
    const size_t kstep = (size_t)(BK * 2);
    const size_t hstep = (size_t)HALF * K * 2;
    const size_t tstep = 2 * hstep;
    const unsigned ldsw = (unsigned)wid * 1024u;
    const int aoff = lds_byte(wr * 64 + fr, fq * 8), boff = lds_byte(wc * 32 + fr, fq * 8);
#define PG8_SA(b, h) (((b) * 2 + (h)) * HTB)
#define PG8_SB(b, h) ((4 + (b) * 2 + (h)) * HTB)
#define PG8_STAGE(bufoff, gbase, voff) do { _Pragma("unroll") for (int _i = 0; _i < 2; ++_i) \
        __builtin_amdgcn_global_load_lds((const unsigned*)((const char*)(gbase) + (voff)[_i]), (PG8_LAS unsigned*)(lds + (bufoff) + ldsw + _i * 8192), 16, 0, 0); } while (0)
#define PG8_LDA(dst, b, h) do { _Pragma("unroll") for (int m = 0; m < 4; ++m) _Pragma("unroll") for (int k = 0; k < 2; ++k) dst[m][k] = *(const PG8_LAS bf16x8*)(lds + PG8_SA(b, h) + aoff + m * 2048 + k * 1024); } while (0)
#define PG8_LDB(dst, b, h) do { _Pragma("unroll") for (int n = 0; n < 2; ++n) _Pragma("unroll") for (int k = 0; k < 2; ++k) dst[n][k] = *(const PG8_LAS bf16x8*)(lds + PG8_SB(b, h) + boff + n * 2048 + k * 1024); } while (0)
#define PG8_MMA(ai, bj, At, Bt) do { __builtin_amdgcn_s_setprio(1); _Pragma("unroll") for (int m = 0; m < 4; ++m) _Pragma("unroll") for (int n = 0; n < 2; ++n) _Pragma("unroll") for (int k = 0; k < 2; ++k) \
        acc[ai][bj][m][n] = __builtin_amdgcn_mfma_f32_16x16x32_bf16(Bt[n][k], At[m][k], acc[ai][bj][m][n], 0, 0, 0); __builtin_amdgcn_s_setprio(0); } while (0)
#define PG8_WAIT_V(n) asm volatile("s_waitcnt vmcnt(" #n ")" ::: "memory")
#define PG8_WAIT_L(n) asm volatile("s_waitcnt lgkmcnt(" #n ")" ::: "memory")
#define PG8_BAR __builtin_amdgcn_s_barrier()
#define PG8_SCHED __builtin_amdgcn_sched_barrier(0)
    Unit cur, nxt; int ui = 0;
    if (!S.next(0, cur)) return;
    f32x4 acc[2][2][4][2];
#pragma unroll
    for (int a = 0; a < 2; ++a)
#pragma unroll
        for (int b = 0; b < 2; ++b)
#pragma unroll
            for (int m = 0; m < 4; ++m)
#pragma unroll
                for (int n = 0; n < 2; ++n) acc[a][b][m][n] = (f32x4){0.f, 0.f, 0.f, 0.f};
    bf16x8 At[4][2], B0[2][2], B1[2][2];
    const char* cA = (const char*)g.A + (size_t)cur.pm * tstep; const char* cB = (const char*)g.Bt + (size_t)cur.pn * tstep;
    S.a_ready(cur);
    if constexpr (SP2) {
        PG8_STAGE(PG8_SB(0, 0), cB, voffB); PG8_STAGE(PG8_SB(0, 1), cB + hstep, voffB); PG8_STAGE(PG8_SA(0, 0), cA, voffA); PG8_STAGE(PG8_SA(0, 1), cA + hstep, voffA);
        if (wr == 1) PG8_BAR;
        PG8_WAIT_V(2); PG8_BAR;
        PG8_STAGE(PG8_SB(1, 0), cB + kstep, voffB); PG8_STAGE(PG8_SA(1, 0), cA + kstep, voffA); PG8_STAGE(PG8_SB(1, 1), cB + hstep + kstep, voffB);
        PG8_WAIT_V(6); PG8_BAR;
    } else {
        PG8_STAGE(PG8_SB(0, 0), cB, voffB); PG8_STAGE(PG8_SA(0, 0), cA, voffA); PG8_STAGE(PG8_SB(0, 1), cB + hstep, voffB); PG8_STAGE(PG8_SA(0, 1), cA + hstep, voffA);
        if (wr == 1) PG8_BAR;
        PG8_WAIT_V(4); PG8_BAR;
        PG8_STAGE(PG8_SB(1, 0), cB + kstep, voffB); PG8_STAGE(PG8_SA(1, 0), cA + kstep, voffA); PG8_STAGE(PG8_SB(1, 1), cB + hstep + kstep, voffB);
        PG8_WAIT_V(6); PG8_BAR;
    }
    for (;;) {
        const bool has_next = S.next(ui + 1, nxt);
        const char* nA = has_next ? (const char*)g.A + (size_t)nxt.pm * tstep : cA; const char* nB = has_next ? (const char*)g.Bt + (size_t)nxt.pn * tstep : cB;
        for (int t = 0; t < nt; t += 2) {
            const bool last = (t == nt - 2);
            const char* a1 = cA + (size_t)(t + 1) * kstep;
            const char* a2 = last ? nA : cA + (size_t)(t + 2) * kstep; const char* b2 = last ? nB : cB + (size_t)(t + 2) * kstep;
            const char* a3 = a2 + kstep; const char* b3 = b2 + kstep;
            if (last && has_next) S.a_ready(nxt);
            if constexpr (SP2) {
            PG8_LDB(B0, 0, 0); PG8_LDB(B1, 0, 1); PG8_SCHED; PG8_LDA(At, 0, 0); PG8_STAGE(PG8_SA(1, 1), a1 + hstep, voffA);
            PG8_WAIT_V(8); PG8_WAIT_L(0); PG8_BAR; PG8_MMA(0, 0, At, B0); PG8_MMA(0, 1, At, B1); PG8_BAR; PG8_SCHED;
            PG8_LDA(At, 0, 1); PG8_STAGE(PG8_SB(0, 0), b2, voffB); PG8_STAGE(PG8_SB(0, 1), b2 + hstep, voffB); PG8_STAGE(PG8_SA(0, 0), a2, voffA);
            PG8_WAIT_V(8); PG8_WAIT_L(0); PG8_BAR; PG8_MMA(1, 0, At, B0); PG8_MMA(1, 1, At, B1); PG8_BAR; PG8_SCHED;
            PG8_LDB(B0, 1, 0); PG8_LDB(B1, 1, 1); PG8_SCHED; PG8_LDA(At, 1, 0); PG8_STAGE(PG8_SA(0, 1), a2 + hstep, voffA);
            PG8_WAIT_V(8); PG8_WAIT_L(0); PG8_BAR; PG8_MMA(0, 0, At, B0); PG8_MMA(0, 1, At, B1); PG8_BAR; PG8_SCHED;
            PG8_LDA(At, 1, 1); PG8_STAGE(PG8_SB(1, 0), b3, voffB); PG8_STAGE(PG8_SB(1, 1), b3 + hstep, voffB); PG8_STAGE(PG8_SA(1, 0), a3, voffA);
            PG8_WAIT_V(8); PG8_WAIT_L(0); PG8_BAR; PG8_MMA(1, 0, At, B0); PG8_MMA(1, 1, At, B1); PG8_BAR; PG8_SCHED;
            } else {
            PG8_LDB(B0, 0, 0); PG8_SCHED; PG8_LDA(At, 0, 0); PG8_STAGE(PG8_SA(1, 1), a1 + hstep, voffA);
            PG8_WAIT_L(8); PG8_BAR; PG8_WAIT_L(0); PG8_MMA(0, 0, At, B0); PG8_BAR; PG8_SCHED;
            PG8_LDB(B1, 0, 1); PG8_STAGE(PG8_SB(0, 0), b2, voffB);
            PG8_BAR; PG8_WAIT_L(0); PG8_MMA(0, 1, At, B1); PG8_BAR;
            PG8_LDA(At, 0, 1); PG8_STAGE(PG8_SA(0, 0), a2, voffA);
            PG8_BAR; PG8_WAIT_L(0); PG8_MMA(1, 0, At, B0); PG8_BAR; PG8_SCHED;
            PG8_STAGE(PG8_SB(0, 1), b2 + hstep, voffB);
            PG8_WAIT_V(6); PG8_BAR; PG8_MMA(1, 1, At, B1); PG8_BAR;
            PG8_LDB(B0, 1, 0); PG8_SCHED; PG8_LDA(At, 1, 0); PG8_STAGE(PG8_SA(0, 1), a2 + hstep, voffA);
            PG8_WAIT_L(8); PG8_BAR; PG8_WAIT_L(0); PG8_MMA(0, 0, At, B0); PG8_BAR; PG8_SCHED;
            PG8_LDB(B1, 1, 1); PG8_STAGE(PG8_SB(1, 0), b3, voffB);
            PG8_BAR; PG8_WAIT_L(0); PG8_MMA(0, 1, At, B1); PG8_BAR;
            PG8_LDA(At, 1, 1); PG8_STAGE(PG8_SA(1, 0), a3, voffA);
            PG8_BAR; PG8_WAIT_L(0); PG8_MMA(1, 0, At, B0); PG8_BAR; PG8_SCHED;
            PG8_STAGE(PG8_SB(1, 1), b3 + hstep, voffB);
            PG8_WAIT_V(6); PG8_BAR; PG8_MMA(1, 1, At, B1); PG8_BAR;
            }
        }
        if constexpr (ALIGN_EPI) { if (wr == 0) PG8_BAR; }
        if constexpr (!Epi::AFTER_DRAIN) { E(acc, cur, wr, wc, fr, fq); S.done(cur); }
        if (!has_next) break;
#pragma unroll
        for (int a = 0; a < 2; ++a)
#pragma unroll
            for (int b = 0; b < 2; ++b)
#pragma unroll
                for (int m = 0; m < 4; ++m)
#pragma unroll
                    for (int n = 0; n < 2; ++n) acc[a][b][m][n] = (f32x4){0.f, 0.f, 0.f, 0.f};
        cur = nxt; cA = nA; cB = nB; ++ui;
        if constexpr (ALIGN_EPI) { if (wr == 1) PG8_BAR; }
    }
    PG8_WAIT_V(0);
    if constexpr (!ALIGN_EPI) { if (wr == 0) PG8_BAR; }
    PG8_BAR;
    if constexpr (Epi::AFTER_DRAIN) { E.fused(acc, cur, wr, wc, fr, fq, lds, wid, lane); S.done(cur); }
#undef PG8_SA
#undef PG8_SB
#undef PG8_STAGE
#undef PG8_LDA
#undef PG8_LDB
#undef PG8_MMA
#undef PG8_WAIT_V
#undef PG8_WAIT_L
#undef PG8_BAR
#undef PG8_SCHED
}
}
constexpr int NWAVES = 8;
#ifndef MK_N_LAUNCHES
#define MK_N_LAUNCHES 1
#endif
constexpr int NPH = 10;
constexpr int N_LAUNCHES = MK_N_LAUNCHES;
static_assert(N_LAUNCHES == 1 || N_LAUNCHES == NPH, "MK_N_LAUNCHES is 1 or NPH");

constexpr int D = 4096, M = 16384, NH = 64, HD = 64, NKV = 8, KVD = NKV * HD, WIN = 128;
constexpr int NMOD = 32768;
constexpr int MOD_A = 0, MOD_KV = 12288, MOD_B = 20480;
constexpr float EPS = 1e-6f;
constexpr float LOG2E = 1.4426950408889634f;
constexpr float QSCALE = 0.125f * LOG2E;

constexpr size_t MiB = 1u << 20;
constexpr size_t WS_CTL = 0, CTL_ZERO_BYTES = 1 * MiB;
constexpr size_t WS_MODP = 1 * MiB;
constexpr size_t WS_MODV = 1 * MiB + 512 * 1024;
constexpr size_t WS_WAIN = 2 * MiB, WS_WAOUT = 130 * MiB, WS_WKV = 162 * MiB, WS_WBIN = 170 * MiB, WS_WBOUT = 234 * MiB;
constexpr size_t WS_HA = 266 * MiB;
constexpr size_t WS_Y = 394 * MiB;
constexpr size_t WS_X1 = 522 * MiB;
constexpr size_t WS_BIG = 778 * MiB;
constexpr size_t WS_Q = WS_BIG, WS_Z = WS_BIG + 128 * MiB, WS_AG = WS_BIG + 256 * MiB, WS_K = WS_BIG + 384 * MiB, WS_V = WS_BIG + 400 * MiB;
constexpr size_t WS_END = 1290 * MiB;
constexpr int CW_TMO = 0, CW_CODE = 1;
constexpr int CW_BAR = 4096;

constexpr int RING_OFF = 0, RING_BYTES = 131072;
constexpr int LDSCTL_OFF = RING_BYTES, MISC_OFF = LDSCTL_OFF + 320;
constexpr int XCH_OFF = LDSCTL_OFF + 1024;
constexpr int LDS_BYTES = 147456;
static_assert(XCH_OFF + 2048 <= LDS_BYTES, "LDS map");

#define GAS __attribute__((address_space(1)))
#define LAS __attribute__((address_space(3)))
typedef unsigned short bf16;
typedef unsigned v4u __attribute__((ext_vector_type(4)));
typedef unsigned v2u __attribute__((ext_vector_type(2)));
typedef float f32x4 __attribute__((ext_vector_type(4)));
typedef GAS unsigned gu32;
#define RLX_AGENT __ATOMIC_RELAXED, __HIP_MEMORY_SCOPE_AGENT
#define LDS_WAIT() asm volatile("s_waitcnt lgkmcnt(0)" ::: "memory")
#define VM_WAIT() asm volatile("s_waitcnt vmcnt(0)" ::: "memory")
__device__ __forceinline__ unsigned f2bf(float f) { unsigned u = __builtin_bit_cast(unsigned, f); return (u + 0x7fffu + ((u >> 16) & 1u)) >> 16; }
__device__ __forceinline__ unsigned pk2(float lo, float hi) { return f2bf(lo) | (f2bf(hi) << 16); }
__device__ __forceinline__ float bflo(unsigned w) { return __builtin_bit_cast(float, w << 16); }
__device__ __forceinline__ float bfhi(unsigned w) { return __builtin_bit_cast(float, w & 0xffff0000u); }
__device__ __forceinline__ float silu(float v) { return v * __builtin_amdgcn_rcpf(1.0f + __expf(-v)); }

#define XB_TMO      128
#define XB_XCNT(j)  (256  + 64 * (j))
#define XB_XSUB(j)  (1280 + 64 * (j))
#define XB_XGEN(j)  (2304 + 64 * (j))
#define XB_TOP      3328
#define XB_TOPGEN   3392
#define XCD_BAR_WORDS 3456
#define XB_SPIN_CAP (1u << 18)

__device__ __forceinline__ unsigned xb_ld(unsigned* p)              { return __hip_atomic_load(p, __ATOMIC_RELAXED, __HIP_MEMORY_SCOPE_AGENT); }
__device__ __forceinline__ unsigned xb_add(unsigned* p, unsigned v) { return __hip_atomic_fetch_add(p, v, __ATOMIC_RELAXED, __HIP_MEMORY_SCOPE_AGENT); }
__device__ __forceinline__ unsigned xb_xcc_id() { return (unsigned)__builtin_amdgcn_s_getreg((3 << 11) | 20) & 0xFu; }
#define XB_SPIN(cond, bar) do { unsigned _sp = 0; while (cond) { __builtin_amdgcn_s_sleep(1); \
    if ((++_sp & 255u) == 0u) { if (xb_ld(&(bar)[XB_TMO])) break; if (_sp > XB_SPIN_CAP) { atomicAdd(&(bar)[XB_TMO], 1u); break; } } } } while (0)

struct XcdBarrier {
    unsigned* bar; unsigned x;
    volatile LAS unsigned* st;
};

__device__ __forceinline__ XcdBarrier xcd_barrier_post(unsigned* bar, volatile LAS unsigned* st) {
    XcdBarrier b; b.bar = bar; b.x = xb_xcc_id(); b.st = st;
    if (threadIdx.x == 0) (void)xb_add(&bar[XB_XCNT(b.x)], 1u);
    return b;
}
__device__ __forceinline__ void xcd_barrier_complete(unsigned* bar, unsigned x, unsigned& nloc, unsigned& nx) {
    const unsigned G = gridDim.x * gridDim.y * gridDim.z;
    unsigned sum, cnt, mine, sp = 0u;
    for (;;) {
        sum = 0u; cnt = 0u; mine = 0u;
#pragma unroll
        for (unsigned j = 0; j < 16; ++j) { const unsigned c = xb_ld(&bar[XB_XCNT(j)]); sum += c; cnt += (c > 0u) ? 1u : 0u; mine = (j == x) ? c : mine; }
        if (sum == G) break;
        __builtin_amdgcn_s_sleep(1);
        if ((++sp & 255u) == 0u) { if (xb_ld(&bar[XB_TMO])) break; if (sp > XB_SPIN_CAP) { atomicAdd(&bar[XB_TMO], 1u); break; } }
    }
    nloc = mine > 0u ? mine : 1u; nx = cnt > 0u ? cnt : 1u;
}

__device__ __forceinline__ void xcd_barrier(const XcdBarrier& b) {
    asm volatile("s_waitcnt vmcnt(0)" ::: "memory");
    __syncthreads();
    if (threadIdx.x == 0) {
        unsigned* bar = b.bar;
        __builtin_amdgcn_s_waitcnt(0);
        unsigned nloc = b.st[0], nx = b.st[1];
        if (nloc == 0u) { xcd_barrier_complete(bar, b.x, nloc, nx); b.st[0] = nloc; b.st[1] = nx; }
        const unsigned old = xb_add(&bar[XB_XSUB(b.x)], 1u);
        const unsigned gen = old / nloc;
        if (old + 1u == (gen + 1u) * nloc) {
            __builtin_amdgcn_fence(__ATOMIC_RELEASE, "agent");
            asm volatile("s_waitcnt vmcnt(0)" ::: "memory");
            const unsigned og = xb_add(&bar[XB_TOP], 1u);
            const unsigned tg = og / nx;
            if (og + 1u == (tg + 1u) * nx) xb_add(&bar[XB_TOPGEN], 1u);
            else XB_SPIN(xb_ld(&bar[XB_TOPGEN]) == tg, bar);
            __builtin_amdgcn_fence(__ATOMIC_ACQUIRE, "agent");
            xb_add(&bar[XB_XGEN(b.x)], 1u);
            asm volatile("s_waitcnt vmcnt(0)" ::: "memory");
        } else {
            XB_SPIN(xb_ld(&bar[XB_XGEN(b.x)]) == gen, bar);
            __builtin_amdgcn_fence(__ATOMIC_ACQUIRE, "agent");
            asm volatile("s_waitcnt vmcnt(0)" ::: "memory");
        }
    }
    __syncthreads();
}

__device__ __forceinline__ float wave_sum(float v) {
#pragma unroll
    for (int o = 1; o < 64; o <<= 1) v += __shfl_xor(v, o);
    return v;
}
__device__ __forceinline__ float bcat(const float* ba, const float* bkv, const float* bb, int n) { return n < MOD_KV ? ba[n] : (n < MOD_B ? bkv[n - MOD_KV] : bb[n - MOD_B]); }

__device__ __forceinline__ void p0_gemv(LAS unsigned char* lds, const float* c, const float* wa, const float* wkv, const float* wb, float* modp, int vcu, int G, int tid, int lane, int wave) {
    LAS float* SC = (LAS float*)lds;
    LAS float* RED = (LAS float*)(lds + 16384);
    for (int i = tid; i < D; i += NWAVES * 64) SC[i] = silu(c[i]);
    __syncthreads();
    for (int u = vcu; u < 256; u += G) {
        const int ch = u >> 1, kh = u & 1;
        const float* W; int pitch, col;
        if (ch < 48) { W = wa; pitch = 12288; col = ch * 256; } else if (ch < 80) { W = wkv; pitch = 8192; col = (ch - 48) * 256; } else { W = wb; pitch = 12288; col = (ch - 80) * 256; }
        const int k0 = kh * 2048 + wave * 256;
        const float* p = W + (size_t)k0 * pitch + col + 4 * lane;
        f32x4 a0 = {0.f, 0.f, 0.f, 0.f}, a1 = a0;
#pragma unroll 4
        for (int k = 0; k < 256; k += 2) {
            const f32x4 w0 = *(const f32x4*)(p + (size_t)k * pitch), w1 = *(const f32x4*)(p + (size_t)(k + 1) * pitch);
            a0 += w0 * SC[k0 + k]; a1 += w1 * SC[k0 + k + 1];
        }
        a0 += a1;
        *(LAS f32x4*)(RED + wave * 256 + 4 * lane) = a0;
        __syncthreads();
        if (tid < 256) { float s = 0.f;
#pragma unroll
            for (int w = 0; w < 8; ++w) s += RED[w * 256 + tid];
            modp[kh * NMOD + ch * 256 + tid] = s; }
        __syncthreads();
    }
}

template <int PERMUTE>
__device__ __forceinline__ void p0_transpose_item(const float* W, int N, bf16* WT, LAS unsigned short* T, int item, int lane) {
    const int nblk = N / 64, kb = item / nblk, nb = item % nblk, k0 = 64 * kb, n0 = 64 * nb;
    f32x4 v[16];
    const int kk0 = lane >> 4, nn = 4 * (lane & 15);
#pragma unroll
    for (int i = 0; i < 16; ++i) v[i] = *(const f32x4*)(W + (size_t)(k0 + 4 * i + kk0) * N + n0 + nn);
#pragma unroll
    for (int i = 0; i < 16; ++i) { const int kk = 4 * i + kk0;
        T[(nn + 0) * 72 + kk] = (unsigned short)f2bf(v[i][0]); T[(nn + 1) * 72 + kk] = (unsigned short)f2bf(v[i][1]);
        T[(nn + 2) * 72 + kk] = (unsigned short)f2bf(v[i][2]); T[(nn + 3) * 72 + kk] = (unsigned short)f2bf(v[i][3]); }
    LDS_WAIT(); asm volatile("" ::: "memory");
    const int c = lane & 7;
#pragma unroll
    for (int j = 0; j < 8; ++j) { const int n = (lane >> 3) + 8 * j;
        const v4u o = *(const LAS v4u*)(T + n * 72 + 8 * c);
        int nsrc = n0 + n, ndst = nsrc;
        if (PERMUTE) {
            const int q = nsrc >> 12, chn = nsrc & 4095;
            ndst = 256 * (chn >> 6) + 128 * (q >> 1) + 32 * ((chn >> 4) & 3) + 8 * ((chn >> 2) & 3) + 4 * (q & 1) + (chn & 3);
        }
        *(v4u*)(WT + (size_t)ndst * D + k0 + 8 * c) = o; }
    LDS_WAIT(); asm volatile("" ::: "memory");
}

template <int NOUT>
__device__ __forceinline__ void norm_rows_bf16(const float* X, bf16* O0, bf16* O1, const LAS float* GS, int gw, int NGW, int lane) {
    for (int m = gw; m < M; m += NGW) {
        asm volatile("" ::: "memory");
        const f32x4* xr = (const f32x4*)(X + (size_t)m * D) + lane;
        f32x4 v[16]; float s = 0.f;
#pragma unroll
        for (int j = 0; j < 16; ++j) { v[j] = xr[64 * j]; s += (v[j][0] * v[j][0] + v[j][1] * v[j][1]) + (v[j][2] * v[j][2] + v[j][3] * v[j][3]); }
        const float rstd = __builtin_amdgcn_rsqf(wave_sum(s) * (1.f / D) + EPS);
#pragma unroll
        for (int o = 0; o < NOUT; ++o) {
            v2u* op = (v2u*)((o == 0 ? O0 : O1) + (size_t)m * D) + lane;
#pragma unroll
            for (int j = 0; j < 16; ++j) {
                const f32x4 g4 = *(const LAS f32x4*)(GS + (o * 2 + 0) * D + 256 * j + 4 * lane), s4 = *(const LAS f32x4*)(GS + (o * 2 + 1) * D + 256 * j + 4 * lane);
                const f32x4 y = v[j] * rstd * g4 + s4;
                v2u w; w.x = pk2(y[0], y[1]); w.y = pk2(y[2], y[3]); op[64 * j] = w; }
        }
    }
}

__device__ __forceinline__ void convgate_naive(const bf16* P, const float* cw, bf16* Y, int gtid, int total) {
    for (size_t idx = (size_t)gtid; idx < (size_t)M * 512; idx += (size_t)total) {
        const int t = (int)(idx >> 9), j = (int)(idx & 511) * 8;
        const bf16* r0 = P + (size_t)t * 16384 + j;
        const v4u zero = {0u, 0u, 0u, 0u};
        const v4u bq = *(const v4u*)(r0), zq = *(const v4u*)(r0 + 12288);
        const v4u c0 = *(const v4u*)(r0 + 4096), u0 = *(const v4u*)(r0 + 8192);
        const v4u c1 = t >= 1 ? *(const v4u*)(r0 - 16384 + 4096) : zero, u1 = t >= 1 ? *(const v4u*)(r0 - 16384 + 8192) : zero;
        const v4u c2 = t >= 2 ? *(const v4u*)(r0 - 32768 + 4096) : zero, u2 = t >= 2 ? *(const v4u*)(r0 - 32768 + 8192) : zero;
        float w0[8], w1[8], w2[8];
#pragma unroll
        for (int e = 0; e < 8; e += 4) { const f32x4 a = *(const f32x4*)(cw + j + e), b = *(const f32x4*)(cw + D + j + e), c = *(const f32x4*)(cw + 2 * D + j + e);
#pragma unroll
            for (int i = 0; i < 4; ++i) { w0[e + i] = a[i]; w1[e + i] = b[i]; w2[e + i] = c[i]; } }
        v4u o;
#pragma unroll
        for (int e = 0; e < 4; ++e) {
            float y[2];
#pragma unroll
            for (int hh = 0; hh < 2; ++hh) {
                const float b = hh ? bfhi(bq[e]) : bflo(bq[e]), z = hh ? bfhi(zq[e]) : bflo(zq[e]);
                const float cu0 = (hh ? bfhi(c0[e]) : bflo(c0[e])) * (hh ? bfhi(u0[e]) : bflo(u0[e]));
                const float cu1 = (hh ? bfhi(c1[e]) : bflo(c1[e])) * (hh ? bfhi(u1[e]) : bflo(u1[e]));
                const float cu2 = (hh ? bfhi(c2[e]) : bflo(c2[e])) * (hh ? bfhi(u2[e]) : bflo(u2[e]));
                const int ee = 2 * e + hh;
                y[hh] = b * (w0[ee] * cu2 + w1[ee] * cu1 + w2[ee] * cu0) * silu(z);
            }
            o[e] = pk2(y[0], y[1]);
        }
        *(v4u*)(Y + (size_t)t * D + j) = o;
    }
}

__device__ __forceinline__ int t5_bucket(int d) { if (d < 16) return d; const int b = 16 + (int)(__log2f((float)d * 0.0625f) * (16.0f / 3.0f)); return b < 31 ? b : 31; }

__device__ __forceinline__ void attn_naive(LAS unsigned char* lds, const bf16* Q, const bf16* K, const bf16* V, const bf16* Z, bf16* O, const float* rel_bias, const float* sinks, int gtid, int total, int tid) {
    LAS float* BT = (LAS float*)lds;
    for (int i = tid; i < NH * WIN; i += NWAVES * 64) { const int h = i >> 7, d = i & 127; BT[i] = rel_bias[t5_bucket(d) * NH + h] * LOG2E; }
    __syncthreads();
    for (int idx = gtid; idx < M * NH; idx += total) {
        const int h = idx >> 14, t = idx & (M - 1), g = h >> 3;
        float q[64], acc[64];
        { const v4u* qp = (const v4u*)(Q + (size_t)t * D + h * 64);
#pragma unroll
          for (int c = 0; c < 8; ++c) { const v4u w = qp[c];
#pragma unroll
              for (int e = 0; e < 4; ++e) { q[8 * c + 2 * e] = bflo(w[e]); q[8 * c + 2 * e + 1] = bfhi(w[e]); } } }
#pragma unroll
        for (int d = 0; d < 64; ++d) acc[d] = 0.f;
        float mx = sinks[h] * LOG2E, l = 1.f;
        const int nd = t < WIN - 1 ? t : WIN - 1;
        for (int i = 0; i <= nd; ++i) {
            const int s = t - i;
            const v4u* kp = (const v4u*)(K + (size_t)s * KVD + g * 64);
            float dot = 0.f;
#pragma unroll
            for (int c = 0; c < 8; ++c) { const v4u w = kp[c];
#pragma unroll
                for (int e = 0; e < 4; ++e) { dot += q[8 * c + 2 * e] * bflo(w[e]); dot += q[8 * c + 2 * e + 1] * bfhi(w[e]); } }
            const float lg = dot + BT[h * WIN + i];
            const float mn = fmaxf(mx, lg), f = __builtin_amdgcn_exp2f(mx - mn), p = __builtin_amdgcn_exp2f(lg - mn);
            l = l * f + p; mx = mn;
            const v4u* vp = (const v4u*)(V + (size_t)s * KVD + g * 64);
#pragma unroll
            for (int c = 0; c < 8; ++c) { const v4u w = vp[c];
#pragma unroll
                for (int e = 0; e < 4; ++e) { acc[8 * c + 2 * e] = acc[8 * c + 2 * e] * f + p * bflo(w[e]); acc[8 * c + 2 * e + 1] = acc[8 * c + 2 * e + 1] * f + p * bfhi(w[e]); } }
        }
        const float inv = 1.0f / l;
        const v4u* zp = (const v4u*)(Z + (size_t)t * D + h * 64); v4u* op = (v4u*)(O + (size_t)t * D + h * 64);
#pragma unroll
        for (int c = 0; c < 8; ++c) { const v4u w = zp[c]; v4u o;
#pragma unroll
            for (int e = 0; e < 4; ++e) o[e] = pk2(acc[8 * c + 2 * e] * inv * bflo(w[e]), acc[8 * c + 2 * e + 1] * inv * bfhi(w[e]));
            op[c] = o; }
    }
}

__device__ __forceinline__ void final_norm(float* X, const LAS float* G, int gw, int NGW, int lane) {
    for (int m = gw; m < M; m += NGW) {
        asm volatile("" ::: "memory");
        f32x4* xr = (f32x4*)(X + (size_t)m * D) + lane;
        f32x4 v[16]; float s = 0.f;
#pragma unroll
        for (int j = 0; j < 16; ++j) { v[j] = xr[64 * j]; s += (v[j][0] * v[j][0] + v[j][1] * v[j][1]) + (v[j][2] * v[j][2] + v[j][3] * v[j][3]); }
        const float rstd = __builtin_amdgcn_rsqf(wave_sum(s) * (1.f / D) + EPS);
#pragma unroll
        for (int j = 0; j < 16; ++j) xr[64 * j] = v[j] * rstd * *(const LAS f32x4*)(G + 256 * j + 4 * lane);
    }
}

struct Args { const float* in[20]; float* out; unsigned char* ws; int ph_lo, ph_hi; };
static_assert(sizeof(Args) == 22 * 8 + 8, "Args has no padding");
__global__ void __launch_bounds__(NWAVES * 64, 2) mk_fwd(Args args) {
    extern __shared__ __attribute__((aligned(16))) unsigned char lds_raw[];
    LAS unsigned char* lds = (LAS unsigned char*)lds_raw;
    volatile LAS unsigned* MISC = (volatile LAS unsigned*)(lds + MISC_OFF);
    const int tid = threadIdx.x, lane = tid & 63, wave = __builtin_amdgcn_readfirstlane(tid >> 6);
    const int G = gridDim.x; const int bx = blockIdx.x; const int vcu = (G % 8 == 0) ? (bx % 8) * (G / 8) + bx / 8 : bx;
    const int gw = vcu * NWAVES + wave, NGW = G * NWAVES, gtid = bx * (NWAVES * 64) + tid, gtotal = G * NWAVES * 64;
    unsigned char* ws = args.ws;
    gu32* ctl = (gu32*)(ws + WS_CTL);
    const float* x = args.in[0]; const float* cvec = args.in[1]; const float* g_a = args.in[2]; const float* w_mod_a = args.in[3]; const float* b_mod_a = args.in[4];
    const float* w_a_in = args.in[5]; const float* conv_a = args.in[6]; const float* w_a_out = args.in[7]; const float* g_kv = args.in[8]; const float* w_mod_kv = args.in[9];
    const float* b_mod_kv = args.in[10]; const float* w_kv = args.in[11]; const float* rel_bias = args.in[12]; const float* g_b = args.in[13]; const float* w_mod_b = args.in[14];
    const float* b_mod_b = args.in[15]; const float* w_b_in = args.in[16]; const float* sinks_b = args.in[17]; const float* w_b_out = args.in[18]; const float* g_final = args.in[19];
    float* out = args.out;
    float* modp = (float*)(ws + WS_MODP); float* modv = (float*)(ws + WS_MODV);
    bf16* W_AIN = (bf16*)(ws + WS_WAIN); bf16* W_AOUT = (bf16*)(ws + WS_WAOUT); bf16* W_KV = (bf16*)(ws + WS_WKV); bf16* W_BIN = (bf16*)(ws + WS_WBIN); bf16* W_BOUT = (bf16*)(ws + WS_WBOUT);
    bf16* HA = (bf16*)(ws + WS_HA); bf16* YB = (bf16*)(ws + WS_Y); float* X1 = (float*)(ws + WS_X1); bf16* PROJ = (bf16*)(ws + WS_BIG);
    bf16* QB = (bf16*)(ws + WS_Q); bf16* ZB = (bf16*)(ws + WS_Z); bf16* AG = (bf16*)(ws + WS_AG); bf16* KB = (bf16*)(ws + WS_K); bf16* VB = (bf16*)(ws + WS_V);

    for (int u = tid; u < (LDS_BYTES - LDSCTL_OFF) / 4; u += NWAVES * 64) ((LAS unsigned*)(lds + LDSCTL_OFF))[u] = 0u;
    __syncthreads();
    XcdBarrier bar; bar.bar = (unsigned*)(ctl + CW_BAR); bar.x = 0; bar.st = nullptr;
    if (N_LAUNCHES == 1) bar = xcd_barrier_post((unsigned*)(ctl + CW_BAR), MISC + 8);
#define GRID_BAR(seam) do { if (N_LAUNCHES != 1) { if (tid == 0) __hip_atomic_store(ctl + CW_TMO, 0xBADBA0u | (unsigned)(seam), RLX_AGENT); } else { xcd_barrier(bar); } } while (0)
    const int lo = args.ph_lo, hi = args.ph_hi;
#define IN(k) (lo <= (k) && (k) < hi)
#define BOTH(k) (IN(k) && IN((k) + 1))

    if (IN(0)) {
        p0_gemv(lds, cvec, w_mod_a, w_mod_kv, w_mod_b, modp, vcu, G, tid, lane, wave);
        LAS unsigned short* T = (LAS unsigned short*)(lds + wave * 9216);
        constexpr int I_AIN = 64 * 256, I_AOUT = 64 * 64, I_KV = 64 * 16, I_BIN = 64 * 128, I_BOUT = 64 * 64, NITEMS = I_AIN + I_AOUT + I_KV + I_BIN + I_BOUT;
        for (int it = gw; it < NITEMS; it += NGW) {
            int r = it;
            if (r < I_AIN) { p0_transpose_item<0>(w_a_in, 16384, W_AIN, T, r, lane); continue; } r -= I_AIN;
            if (r < I_AOUT) { p0_transpose_item<0>(w_a_out, 4096, W_AOUT, T, r, lane); continue; } r -= I_AOUT;
            if (r < I_KV) { p0_transpose_item<0>(w_kv, 1024, W_KV, T, r, lane); continue; } r -= I_KV;
            if (r < I_BIN) { p0_transpose_item<0>(w_b_in, 8192, W_BIN, T, r, lane); continue; } r -= I_BIN;
            p0_transpose_item<0>(w_b_out, 4096, W_BOUT, T, r, lane);
        }
        if (BOTH(0)) GRID_BAR(0);
    }
    if (IN(1)) {
        LAS float* GS = (LAS float*)lds;
        for (int i = tid; i < D; i += NWAVES * 64) {
            const float sh = b_mod_a[i] + modp[MOD_A + i] + modp[NMOD + MOD_A + i];
            const float sc = b_mod_a[D + i] + modp[MOD_A + D + i] + modp[NMOD + MOD_A + D + i];
            GS[i] = g_a[i] * (1.0f + sc); GS[D + i] = sh; }
        for (int n = gtid; n < NMOD; n += gtotal) modv[n] = bcat(b_mod_a, b_mod_kv, b_mod_b, n) + modp[n] + modp[NMOD + n];
        __syncthreads();
        norm_rows_bf16<1>(x, HA, nullptr, GS, gw, NGW, lane);
        __syncthreads();
        if (BOTH(1)) GRID_BAR(1);
    }
    if (IN(2)) {
        pg8::Gemm g{HA, W_AIN, M, 4 * D, D}; pg8::StaticOrder S; S.init(M, 4 * D, G, bx);
        pg8::EpiBf16S E{PROJ, 4 * D, 0, 0, 1.f, 0};
        pg8::gemm_phase<pg8::EpiBf16S, pg8::StaticOrder, true, true>(lds + RING_OFF, g, S, E);
        if (BOTH(2)) GRID_BAR(2);
    }
    if (IN(3)) {
        convgate_naive(PROJ, conv_a, YB, gtid, gtotal);
        if (BOTH(3)) GRID_BAR(3);
    }
    if (IN(4)) {
        pg8::Gemm g{YB, W_AOUT, M, D, D}; pg8::StaticOrder S; S.init(M, D, G, bx);
        pg8::EpiResGate E{x, X1, D, modv + MOD_A + 2 * D};
        pg8::gemm_phase<pg8::EpiResGate, pg8::StaticOrder, true, true>(lds + RING_OFF, g, S, E);
        if (BOTH(4)) GRID_BAR(4);
    }
    if (IN(5)) {
        LAS float* GS = (LAS float*)lds;
        for (int i = tid; i < D; i += NWAVES * 64) {
            GS[i] = g_kv[i] * (1.0f + modv[MOD_KV + D + i]); GS[D + i] = modv[MOD_KV + i];
            GS[2 * D + i] = g_b[i] * (1.0f + modv[MOD_B + D + i]); GS[3 * D + i] = modv[MOD_B + i]; }
        __syncthreads();
        norm_rows_bf16<2>(X1, HA, YB, GS, gw, NGW, lane);
        __syncthreads();
        if (BOTH(5)) GRID_BAR(5);
    }
    if (IN(6)) {
        { pg8::Gemm g{HA, W_KV, M, 2 * KVD, D}; pg8::StaticOrder S; S.init(M, 2 * KVD, G, bx);
          pg8::EpiBf16S E{KB, KVD, KVD, (size_t)(WS_V - WS_K) / 2, 1.f, 0};
          pg8::gemm_phase<pg8::EpiBf16S, pg8::StaticOrder, true, true>(lds + RING_OFF, g, S, E); }
        { pg8::Gemm g{YB, W_BIN, M, 2 * D, D}; pg8::StaticOrder S; S.init(M, 2 * D, G, bx);
          pg8::EpiBf16S E{QB, D, D, (size_t)(WS_Z - WS_Q) / 2, QSCALE, 1};
          pg8::gemm_phase<pg8::EpiBf16S, pg8::StaticOrder, true, true>(lds + RING_OFF, g, S, E); }
        if (BOTH(6)) GRID_BAR(6);
    }
    if (IN(7)) {
        attn_naive(lds, QB, KB, VB, ZB, AG, rel_bias, sinks_b, gtid, gtotal, tid);
        __syncthreads();
        if (BOTH(7)) GRID_BAR(7);
    }
    if (IN(8)) {
        pg8::Gemm g{AG, W_BOUT, M, D, D}; pg8::StaticOrder S; S.init(M, D, G, bx);
        pg8::EpiResGate E{X1, out, D, modv + MOD_B + 2 * D};
        pg8::gemm_phase<pg8::EpiResGate, pg8::StaticOrder, true, true>(lds + RING_OFF, g, S, E);
        if (BOTH(8)) GRID_BAR(8);
    }
    if (IN(9)) {
        LAS float* GF = (LAS float*)lds;
        for (int i = tid; i < D; i += NWAVES * 64) GF[i] = g_final[i];
        __syncthreads();
        final_norm(out, GF, gw, NGW, lane);
    }
#undef IN
#undef BOTH
}

extern "C" void kernel_launch(void* const* d_in, const int* in_sizes, int n_in, void* d_out, int out_size, void* d_ws, size_t ws_size, hipStream_t stream) {
    static int grid = 0;
    if (grid == 0) {
        if (n_in != 20 || in_sizes[0] != M * D || out_size != M * D || ws_size < WS_END) { fprintf(stderr, "kernel_launch: built for 20 inputs, x/out of %d floats, >= %zu bytes of workspace; got n_in %d, in0 %d, out %d, ws %zu; nothing launched\n", M * D, (size_t)WS_END, n_in, n_in > 0 ? in_sizes[0] : -1, out_size, ws_size); grid = -1; return; }
        int dev = 0, cus = 0, per_cu = 0;
        if (hipGetDevice(&dev) != hipSuccess || hipDeviceGetAttribute(&cus, hipDeviceAttributeMultiprocessorCount, dev) != hipSuccess) { fprintf(stderr, "kernel_launch: hipGetDevice / hipDeviceGetAttribute failed\n"); grid = -1; return; }
        if (hipFuncSetAttribute((const void*)mk_fwd, hipFuncAttributeMaxDynamicSharedMemorySize, LDS_BYTES) != hipSuccess) { fprintf(stderr, "kernel_launch: hipFuncSetAttribute failed\n"); grid = -1; return; }
        if (hipOccupancyMaxActiveBlocksPerMultiprocessor(&per_cu, (const void*)mk_fwd, NWAVES * 64, LDS_BYTES) != hipSuccess || per_cu < 1)
            fprintf(stderr, "kernel_launch: note: the occupancy query reports %d workgroups per CU\n", per_cu);
        (void)hipGetLastError();
        grid = cus;
    }
    if (grid < 0) return;
    if (hipMemsetAsync((char*)d_ws + WS_CTL, 0, CTL_ZERO_BYTES, stream) != hipSuccess) { fprintf(stderr, "kernel_launch: hipMemsetAsync failed\n"); return; }
    Args a{};
    for (int i = 0; i < 20; ++i) a.in[i] = (const float*)d_in[i];
    a.out = (float*)d_out; a.ws = (unsigned char*)d_ws;
    for (int li = 0; li < N_LAUNCHES; ++li) {
        a.ph_lo = (N_LAUNCHES == 1) ? 0 : li; a.ph_hi = (N_LAUNCHES == 1) ? NPH : li + 1;
        hipLaunchKernelGGL(mk_fwd, dim3(grid), dim3(NWAVES * 64), LDS_BYTES, stream, a);
        const hipError_t le = hipPeekAtLastError();
        if (le != hipSuccess) { fprintf(stderr, "kernel_launch: launch %d failed: %s\n", li, hipGetErrorName(le)); break; }
    }
}
```

```cpp
#include <hip/hip_runtime.h>
#include <cstdio>
#include <cstdint>
namespace pg8 {
#define PG8_LAS __attribute__((address_space(3)))
typedef unsigned short bf16_t;
typedef short bf16x8 __attribute__((ext_vector_type(8)));
typedef float f32x4 __attribute__((ext_vector_type(4)));
typedef unsigned u32x4 __attribute__((ext_vector_type(4)));
constexpr int BM = 256, BK = 64, HALF = 128, HTB = HALF * BK * 2  , STAGE_BYTES = 8 * HTB, NXCD = 8, WGM = 8;

__host__ __device__ __forceinline__ int lds_byte(int r, int c) { const int st = (r >> 4) * 2 + (c >> 5), rr = r & 15, cc = c & 31, ob = rr * 64 + cc * 2; return st * 1024 + (ob ^ (((ob >> 9) & 1) << 5)); }
__host__ __device__ __forceinline__ void stage_rc(int b, int& R, int& C) { const int st = b / 1024, sb = b % 1024, swz = sb ^ (((sb >> 9) & 1) << 5); R = (st >> 1) * 16 + swz / 64; C = (st & 1) * 32 + (swz % 64) / 2; }
__host__ __device__ __forceinline__ int perm32(int rho) { const int n = rho >> 4, i = rho & 15; return 8 * (i >> 2) + 4 * n + (i & 3); }

struct Unit { int pm, pn; };
struct Gemm { const bf16_t* A; const bf16_t* Bt; int M, N, K; };

struct StaticOrder {
    int nM, nN, nwg, G, c;
    __host__ __device__ void init(int M, int N, int G_, int c_) { nM = M / BM; nN = N / BM; nwg = nM * nN; G = G_; c = c_; }
    __host__ __device__ bool next(int i, Unit& u) const {
        const long L = (long)i * G + c; if (L >= nwg) return false;
        int wgid = (int)L; { const int q = nwg / NXCD, r = nwg % NXCD, xcd = wgid % NXCD, off = wgid / NXCD; wgid = (xcd < r ? xcd * (q + 1) : r * (q + 1) + (xcd - r) * q) + off; }
        const int nig = WGM * nN, gid = wgid / nig, fm = gid * WGM, gsz = (nM - fm) < WGM ? (nM - fm) : WGM;
        u.pm = fm + ((wgid % nig) % gsz); u.pn = (wgid % nig) / gsz; return true;
    }
    __device__ __forceinline__ void a_ready(const Unit&) const {}
    __device__ __forceinline__ void done(const Unit&) const {}
};
__device__ __forceinline__ unsigned cvt_pk_bf16(float lo, float hi) { unsigned r; asm volatile("v_cvt_pk_bf16_f32 %0, %1, %2" : "=v"(r) : "v"(lo), "v"(hi)); return r; }
__device__ __forceinline__ float silu_f(float v) { return v * __builtin_amdgcn_rcpf(1.0f + __expf(-v)); }

struct EpiBf16S {
    static constexpr bool PERM = true, AFTER_DRAIN = false;
    bf16_t* O; int ldc; int split_cols; size_t split_stride; float scale0; int silu1;
    __device__ __forceinline__ void operator()(const f32x4 (&acc)[2][2][4][2], const Unit& u, int wr, int wc, int fr, int fq) const {
        const int row0 = u.pm * BM + wr * 64 + fr; int colt = u.pn * BM; bf16_t* base = O;
        float sc = 1.f; bool act = false;
        if (split_cols) { const int t = colt / split_cols; base += (size_t)t * split_stride; colt -= t * split_cols; if (t == 0) sc = scale0; else act = (silu1 != 0); }
        const int col0 = colt + wc * 32 + 8 * fq;
#pragma unroll
        for (int ai = 0; ai < 2; ++ai)
#pragma unroll
            for (int m = 0; m < 4; ++m) { bf16_t* rowp = base + (size_t)(row0 + ai * HALF + m * 16) * ldc + col0;
#pragma unroll
                for (int bj = 0; bj < 2; ++bj) { f32x4 v0 = acc[ai][bj][m][0], v1 = acc[ai][bj][m][1];
                    if (act) { v0 = (f32x4){silu_f(v0[0]), silu_f(v0[1]), silu_f(v0[2]), silu_f(v0[3])}; v1 = (f32x4){silu_f(v1[0]), silu_f(v1[1]), silu_f(v1[2]), silu_f(v1[3])}; }
                    v0 = v0 * sc; v1 = v1 * sc; u32x4 w; w.x = cvt_pk_bf16(v0[0], v0[1]); w.y = cvt_pk_bf16(v0[2], v0[3]); w.z = cvt_pk_bf16(v1[0], v1[1]); w.w = cvt_pk_bf16(v1[2], v1[3]);
                    *(u32x4*)(rowp + bj * HALF) = w; } }
    }
};

struct EpiResGate {
    static constexpr bool PERM = false, AFTER_DRAIN = false;
    const float* base; float* out; int ldc; const float* gate;
    __device__ __forceinline__ void operator()(const f32x4 (&acc)[2][2][4][2], const Unit& u, int wr, int wc, int fr, int fq) const {
        const int col0 = u.pn * BM + wc * 32 + 4 * fq;
        f32x4 gv[2][2];
#pragma unroll
        for (int bj = 0; bj < 2; ++bj)
#pragma unroll
            for (int n = 0; n < 2; ++n) gv[bj][n] = *(const f32x4*)(gate + col0 + bj * HALF + n * 16);
#pragma unroll
        for (int ai = 0; ai < 2; ++ai)
#pragma unroll
            for (int m = 0; m < 4; ++m) { const size_t off = (size_t)(u.pm * BM + ai * HALF + wr * 64 + m * 16 + fr) * ldc + col0;
#pragma unroll
                for (int bj = 0; bj < 2; ++bj)
#pragma unroll
                    for (int n = 0; n < 2; ++n) { const f32x4 bs = *(const f32x4*)(base + off + bj * HALF + n * 16);
                        *(f32x4*)(out + off + bj * HALF + n * 16) = bs + gv[bj][n] * acc[ai][bj][m][n]; }
                if (m & 1) asm volatile("" ::: "memory"); }
    }
};

template <int N> __device__ __forceinline__ float row_shr1(float v) { return __builtin_bit_cast(float, __builtin_amdgcn_update_dpp(0, __builtin_bit_cast(int, v), 0x110 + N, 0xf, 0xf, true)); }
template <int N> __device__ __forceinline__ f32x4 row_shr4(f32x4 v) {
    const float a = row_shr1<N>(v[0]), b = row_shr1<N>(v[1]), c = row_shr1<N>(v[2]), d = row_shr1<N>(v[3]);
    return (f32x4){a, b, c, d};
}
struct EpiConvGate {
    static constexpr bool PERM = true, AFTER_DRAIN = false;
    bf16_t* Y; const float* cw; float* CUH; float* BSH; float* PCH; PG8_LAS float* XCH;
    __device__ __forceinline__ void operator()(const f32x4 (&acc)[2][2][4][2], const Unit& u, int wr, int wc, int fr, int fq) const {
        const int chl = 16 * wc + 4 * fq, ch0 = 64 * u.pn + chl;
        f32x4 cu[2][4];
#pragma unroll
        for (int ai = 0; ai < 2; ++ai)
#pragma unroll
            for (int m = 0; m < 4; ++m) cu[ai][m] = acc[ai][0][m][1] * acc[ai][1][m][0];
        if (fr >= 14) {
#pragma unroll
            for (int ai = 0; ai < 2; ++ai)
#pragma unroll
                for (int m = 0; m < 4; ++m) *(PG8_LAS f32x4*)(XCH + ((8 * ai + 4 * wr + m) * 2 + (fr - 14)) * 64 + chl) = cu[ai][m];
            if (wr == 1) *(f32x4*)(CUH + ((size_t)u.pm * 2 + (fr - 14)) * 4096 + ch0) = cu[1][3];
        }
        const f32x4 w0 = *(const f32x4*)(cw + ch0), w1 = *(const f32x4*)(cw + 4096 + ch0), w2 = *(const f32x4*)(cw + 8192 + ch0);
        asm volatile("s_waitcnt lgkmcnt(0)" ::: "memory"); __builtin_amdgcn_s_barrier(); asm volatile("" ::: "memory");
#pragma unroll
        for (int ai = 0; ai < 2; ++ai)
#pragma unroll
            for (int m = 0; m < 4; ++m) {
                const int gi = 8 * ai + 4 * wr + m;
                f32x4 h0 = {0.f, 0.f, 0.f, 0.f}, h1 = h0;
                if (gi > 0 && fr < 2) { h0 = *(const PG8_LAS f32x4*)(XCH + ((gi - 1) * 2 + 0) * 64 + chl); h1 = *(const PG8_LAS f32x4*)(XCH + ((gi - 1) * 2 + 1) * 64 + chl); }
                f32x4 p1 = row_shr4<1>(cu[ai][m]), p2 = row_shr4<2>(cu[ai][m]);
                if (fr == 0) { p1 = h1; p2 = h0; } else if (fr == 1) { p2 = h1; }
                const f32x4 conv = w0 * p2 + w1 * p1 + w2 * cu[ai][m];
                const f32x4 b = acc[ai][0][m][0], z = acc[ai][1][m][1];
                const f32x4 bs = {b[0] * silu_f(z[0]), b[1] * silu_f(z[1]), b[2] * silu_f(z[2]), b[3] * silu_f(z[3])};
                const f32x4 y = bs * conv;
                const size_t row = (size_t)u.pm * BM + ai * HALF + wr * 64 + m * 16 + fr;
                typedef unsigned u32x2 __attribute__((ext_vector_type(2)));
                u32x2 w; w.x = cvt_pk_bf16(y[0], y[1]); w.y = cvt_pk_bf16(y[2], y[3]);
                *(u32x2*)(Y + row * 4096 + ch0) = w;
                if (gi == 0 && fr < 2) { *(f32x4*)(BSH + ((size_t)u.pm * 2 + fr) * 4096 + ch0) = bs; *(f32x4*)(PCH + ((size_t)u.pm * 2 + fr) * 4096 + ch0) = conv; }
            }
    }
};

template <class Epi, class Sched, bool ALIGN_EPI = false, bool SP2 = false>
__device__ __forceinline__ void gemm_phase(PG8_LAS unsigned char* lds, const Gemm g, const Sched& S, const Epi& E) {
    const int tid = threadIdx.x, wid = __builtin_amdgcn_readfirstlane(tid >> 6), lane = tid & 63, wr = wid >> 2, wc = wid & 3, fr = lane & 15, fq = lane >> 4;
    const int K = g.K, nt = K / BK;
    unsigned voffA[2], voffB[2];
#pragma unroll
    for (int i = 0; i < 2; ++i) { int R, C; stage_rc(tid * 16 + i * 8192, R, C); const int Rb = Epi::PERM ? ((R & ~31) + perm32(R & 31)) : R;
        voffA[i] = (unsigned)(R * K + C) * 2u; voffB[i] = (unsigned)(Rb * K + C) * 2u; }
    const size_t kstep = (size_t)(BK * 2);
    const size_t hstep = (size_t)HALF * K * 2;
    const size_t tstep = 2 * hstep;
    const unsigned ldsw = (unsigned)wid * 1024u;
    const int aoff = lds_byte(wr * 64 + fr, fq * 8), boff = lds_byte(wc * 32 + fr, fq * 8);
#define PG8_SA(b, h) (((b) * 2 + (h)) * HTB)
#define PG8_SB(b, h) ((4 + (b) * 2 + (h)) * HTB)
#define PG8_STAGE(bufoff, gbase, voff) do { _Pragma("unroll") for (int _i = 0; _i < 2; ++_i) \
        __builtin_amdgcn_global_load_lds((const unsigned*)((const char*)(gbase) + (voff)[_i]), (PG8_LAS unsigned*)(lds + (bufoff) + ldsw + _i * 8192), 16, 0, 0); } while (0)
#define PG8_LDA(dst, b, h) do { _Pragma("unroll") for (int m = 0; m < 4; ++m) _Pragma("unroll") for (int k = 0; k < 2; ++k) dst[m][k] = *(const PG8_LAS bf16x8*)(lds + PG8_SA(b, h) + aoff + m * 2048 + k * 1024); } while (0)
#define PG8_LDB(dst, b, h) do { _Pragma("unroll") for (int n = 0; n < 2; ++n) _Pragma("unroll") for (int k = 0; k < 2; ++k) dst[n][k] = *(const PG8_LAS bf16x8*)(lds + PG8_SB(b, h) + boff + n * 2048 + k * 1024); } while (0)
#define PG8_MMA(ai, bj, At, Bt) do { __builtin_amdgcn_s_setprio(1); _Pragma("unroll") for (int m = 0; m < 4; ++m) _Pragma("unroll") for (int n = 0; n < 2; ++n) _Pragma("unroll") for (int k = 0; k < 2; ++k) \
        acc[ai][bj][m][n] = __builtin_amdgcn_mfma_f32_16x16x32_bf16(Bt[n][k], At[m][k], acc[ai][bj][m][n], 0, 0, 0); __builtin_amdgcn_s_setprio(0); } while (0)
#define PG8_WAIT_V(n) asm volatile("s_waitcnt vmcnt(" #n ")" ::: "memory")
#define PG8_WAIT_L(n) asm volatile("s_waitcnt lgkmcnt(" #n ")" ::: "memory")
#define PG8_BAR __builtin_amdgcn_s_barrier()
#define PG8_SCHED __builtin_amdgcn_sched_barrier(0)
    Unit cur, nxt; int ui = 0;
    if (!S.next(0, cur)) return;
    f32x4 acc[2][2][4][2];
#pragma unroll
    for (int a = 0; a < 2; ++a)
#pragma unroll
        for (int b = 0; b < 2; ++b)
#pragma unroll
            for (int m = 0; m < 4; ++m)
#pragma unroll
                for (int n = 0; n < 2; ++n) acc[a][b][m][n] = (f32x4){0.f, 0.f, 0.f, 0.f};
    bf16x8 At[4][2], B0[2][2], B1[2][2];
    const char* cA = (const char*)g.A + (size_t)cur.pm * tstep; const char* cB = (const char*)g.Bt + (size_t)cur.pn * tstep;
    S.a_ready(cur);
    if constexpr (SP2) {
        PG8_STAGE(PG8_SB(0, 0), cB, voffB); PG8_STAGE(PG8_SB(0, 1), cB + hstep, voffB); PG8_STAGE(PG8_SA(0, 0), cA, voffA); PG8_STAGE(PG8_SA(0, 1), cA + hstep, voffA);
        if (wr == 1) PG8_BAR;
        PG8_WAIT_V(2); PG8_BAR;
        PG8_STAGE(PG8_SB(1, 0), cB + kstep, voffB); PG8_STAGE(PG8_SA(1, 0), cA + kstep, voffA); PG8_STAGE(PG8_SB(1, 1), cB + hstep + kstep, voffB);
        PG8_WAIT_V(6); PG8_BAR;
    } else {
        PG8_STAGE(PG8_SB(0, 0), cB, voffB); PG8_STAGE(PG8_SA(0, 0), cA, voffA); PG8_STAGE(PG8_SB(0, 1), cB + hstep, voffB); PG8_STAGE(PG8_SA(0, 1), cA + hstep, voffA);
        if (wr == 1) PG8_BAR;
        PG8_WAIT_V(4); PG8_BAR;
        PG8_STAGE(PG8_SB(1, 0), cB + kstep, voffB); PG8_STAGE(PG8_SA(1, 0), cA + kstep, voffA); PG8_STAGE(PG8_SB(1, 1), cB + hstep + kstep, voffB);
        PG8_WAIT_V(6); PG8_BAR;
    }
    for (;;) {
        const bool has_next = S.next(ui + 1, nxt);
        const char* nA = has_next ? (const char*)g.A + (size_t)nxt.pm * tstep : cA; const char* nB = has_next ? (const char*)g.Bt + (size_t)nxt.pn * tstep : cB;
        for (int t = 0; t < nt; t += 2) {
            const bool last = (t == nt - 2);
            const char* a1 = cA + (size_t)(t + 1) * kstep;
            const char* a2 = last ? nA : cA + (size_t)(t + 2) * kstep; const char* b2 = last ? nB : cB + (size_t)(t + 2) * kstep;
            const char* a3 = a2 + kstep; const char* b3 = b2 + kstep;
            if (last && has_next) S.a_ready(nxt);
            if constexpr (SP2) {
            PG8_LDB(B0, 0, 0); PG8_LDB(B1, 0, 1); PG8_SCHED; PG8_LDA(At, 0, 0); PG8_STAGE(PG8_SA(1, 1), a1 + hstep, voffA);
            PG8_WAIT_V(8); PG8_WAIT_L(0); PG8_BAR; PG8_MMA(0, 0, At, B0); PG8_MMA(0, 1, At, B1); PG8_BAR; PG8_SCHED;
            PG8_LDA(At, 0, 1); PG8_STAGE(PG8_SB(0, 0), b2, voffB); PG8_STAGE(PG8_SB(0, 1), b2 + hstep, voffB); PG8_STAGE(PG8_SA(0, 0), a2, voffA);
            PG8_WAIT_V(8); PG8_WAIT_L(0); PG8_BAR; PG8_MMA(1, 0, At, B0); PG8_MMA(1, 1, At, B1); PG8_BAR; PG8_SCHED;
            PG8_LDB(B0, 1, 0); PG8_LDB(B1, 1, 1); PG8_SCHED; PG8_LDA(At, 1, 0); PG8_STAGE(PG8_SA(0, 1), a2 + hstep, voffA);
            PG8_WAIT_V(8); PG8_WAIT_L(0); PG8_BAR; PG8_MMA(0, 0, At, B0); PG8_MMA(0, 1, At, B1); PG8_BAR; PG8_SCHED;
            PG8_LDA(At, 1, 1); PG8_STAGE(PG8_SB(1, 0), b3, voffB); PG8_STAGE(PG8_SB(1, 1), b3 + hstep, voffB); PG8_STAGE(PG8_SA(1, 0), a3, voffA);
            PG8_WAIT_V(8); PG8_WAIT_L(0); PG8_BAR; PG8_MMA(1, 0, At, B0); PG8_MMA(1, 1, At, B1); PG8_BAR; PG8_SCHED;
            } else {
            PG8_LDB(B0, 0, 0); PG8_SCHED; PG8_LDA(At, 0, 0); PG8_STAGE(PG8_SA(1, 1), a1 + hstep, voffA);
            PG8_WAIT_L(8); PG8_BAR; PG8_WAIT_L(0); PG8_MMA(0, 0, At, B0); PG8_BAR; PG8_SCHED;
            PG8_LDB(B1, 0, 1); PG8_STAGE(PG8_SB(0, 0), b2, voffB);
            PG8_BAR; PG8_WAIT_L(0); PG8_MMA(0, 1, At, B1); PG8_BAR;
            PG8_LDA(At, 0, 1); PG8_STAGE(PG8_SA(0, 0), a2, voffA);
            PG8_BAR; PG8_WAIT_L(0); PG8_MMA(1, 0, At, B0); PG8_BAR; PG8_SCHED;
            PG8_STAGE(PG8_SB(0, 1), b2 + hstep, voffB);
            PG8_WAIT_V(6); PG8_BAR; PG8_MMA(1, 1, At, B1); PG8_BAR;
            PG8_LDB(B0, 1, 0); PG8_SCHED; PG8_LDA(At, 1, 0); PG8_STAGE(PG8_SA(0, 1), a2 + hstep, voffA);
            PG8_WAIT_L(8); PG8_BAR; PG8_WAIT_L(0); PG8_MMA(0, 0, At, B0); PG8_BAR; PG8_SCHED;
            PG8_LDB(B1, 1, 1); PG8_STAGE(PG8_SB(1, 0), b3, voffB);
            PG8_BAR; PG8_WAIT_L(0); PG8_MMA(0, 1, At, B1); PG8_BAR;
            PG8_LDA(At, 1, 1); PG8_STAGE(PG8_SA(1, 0), a3, voffA);
            PG8_BAR; PG8_WAIT_L(0); PG8_MMA(1, 0, At, B0); PG8_BAR; PG8_SCHED;
            PG8_STAGE(PG8_SB(1, 1), b3 + hstep, voffB);
            PG8_WAIT_V(6); PG8_BAR; PG8_MMA(1, 1, At, B1); PG8_BAR;
            }
        }
        if constexpr (ALIGN_EPI) { if (wr == 0) PG8_BAR; }
        if constexpr (!Epi::AFTER_DRAIN) { E(acc, cur, wr, wc, fr, fq); S.done(cur); }
        if (!has_next) break;
#pragma unroll
        for (int a = 0; a < 2; ++a)
#pragma unroll
            for (int b = 0; b < 2; ++b)
#pragma unroll
                for (int m = 0; m < 4; ++m)
#pragma unroll
                    for (int n = 0; n < 2; ++n) acc[a][b][m][n] = (f32x4){0.f, 0.f, 0.f, 0.f};
        cur = nxt; cA = nA; cB = nB; ++ui;
        if constexpr (ALIGN_EPI) { if (wr == 1) PG8_BAR; }
    }
    PG8_WAIT_V(0);
    if constexpr (!ALIGN_EPI) { if (wr == 0) PG8_BAR; }
    PG8_BAR;
    if constexpr (Epi::AFTER_DRAIN) { E.fused(acc, cur, wr, wc, fr, fq, lds, wid, lane); S.done(cur); }
#undef PG8_SA
#undef PG8_SB
#undef PG8_STAGE
#undef PG8_LDA
#undef PG8_LDB
#undef PG8_MMA
#undef PG8_WAIT_V
#undef PG8_WAIT_L
#undef PG8_BAR
#undef PG8_SCHED
}
}
constexpr int NWAVES = 8;
#ifndef MK_N_LAUNCHES
#define MK_N_LAUNCHES 1
#endif
#ifndef USE_FUSED_CONV
#define USE_FUSED_CONV 1
#endif
#ifndef USE_MFMA_ATTN
#define USE_MFMA_ATTN 1
#endif
constexpr int NPH = 10;
constexpr int N_LAUNCHES = MK_N_LAUNCHES;
static_assert(N_LAUNCHES == 1 || N_LAUNCHES == NPH, "MK_N_LAUNCHES is 1 or NPH");

constexpr int D = 4096, M = 16384, NH = 64, HD = 64, NKV = 8, KVD = NKV * HD, WIN = 128;
constexpr int NMOD = 32768;
constexpr int MOD_A = 0, MOD_KV = 12288, MOD_B = 20480;
constexpr float EPS = 1e-6f;
constexpr float LOG2E = 1.4426950408889634f;
constexpr float QSCALE = 0.125f * LOG2E;

constexpr size_t MiB = 1u << 20;
constexpr size_t WS_CTL = 0, CTL_ZERO_BYTES = 1 * MiB;
constexpr size_t WS_MODP = 1 * MiB;
constexpr size_t WS_MODV = 1 * MiB + 512 * 1024;
constexpr size_t WS_WAIN = 2 * MiB, WS_WAOUT = 130 * MiB, WS_WKV = 162 * MiB, WS_WBIN = 170 * MiB, WS_WBOUT = 234 * MiB;
constexpr size_t WS_HA = 266 * MiB;
constexpr size_t WS_Y = 394 * MiB;
constexpr size_t WS_X1 = 522 * MiB;
constexpr size_t WS_BIG = 778 * MiB;
constexpr size_t WS_Q = WS_BIG, WS_Z = WS_BIG + 128 * MiB, WS_AG = WS_BIG + 256 * MiB, WS_K = WS_BIG + 384 * MiB, WS_V = WS_BIG + 400 * MiB;
constexpr size_t WS_HALO = WS_BIG + 416 * MiB;
constexpr size_t WS_END = 1290 * MiB;
constexpr int CW_TMO = 0, CW_CODE = 1;
constexpr int CW_BAR = 4096;

constexpr int RING_OFF = 0, RING_BYTES = 131072;
constexpr int LDSCTL_OFF = RING_BYTES, MISC_OFF = LDSCTL_OFF + 320;
constexpr int XCH_OFF = LDSCTL_OFF + 1024;
constexpr int LDS_BYTES = 147456;
static_assert(XCH_OFF + 8192 <= LDS_BYTES, "LDS map");

#define GAS __attribute__((address_space(1)))
#define LAS __attribute__((address_space(3)))
typedef unsigned short bf16;
typedef unsigned v4u __attribute__((ext_vector_type(4)));
typedef unsigned v2u __attribute__((ext_vector_type(2)));
typedef float f32x4 __attribute__((ext_vector_type(4)));
typedef GAS unsigned gu32;
#define RLX_AGENT __ATOMIC_RELAXED, __HIP_MEMORY_SCOPE_AGENT
#define LDS_WAIT() asm volatile("s_waitcnt lgkmcnt(0)" ::: "memory")
#define VM_WAIT() asm volatile("s_waitcnt vmcnt(0)" ::: "memory")
__device__ __forceinline__ unsigned f2bf(float f) { unsigned u = __builtin_bit_cast(unsigned, f); return (u + 0x7fffu + ((u >> 16) & 1u)) >> 16; }
__device__ __forceinline__ unsigned pk2(float lo, float hi) { return f2bf(lo) | (f2bf(hi) << 16); }
__device__ __forceinline__ float bflo(unsigned w) { return __builtin_bit_cast(float, w << 16); }
__device__ __forceinline__ float bfhi(unsigned w) { return __builtin_bit_cast(float, w & 0xffff0000u); }
__device__ __forceinline__ float silu(float v) { return v * __builtin_amdgcn_rcpf(1.0f + __expf(-v)); }

#define XB_TMO      128
#define XB_XCNT(j)  (256  + 64 * (j))
#define XB_XSUB(j)  (1280 + 64 * (j))
#define XB_XGEN(j)  (2304 + 64 * (j))
#define XB_TOP      3328
#define XB_TOPGEN   3392
#define XCD_BAR_WORDS 3456
#define XB_SPIN_CAP (1u << 18)

__device__ __forceinline__ unsigned xb_ld(unsigned* p)              { return __hip_atomic_load(p, __ATOMIC_RELAXED, __HIP_MEMORY_SCOPE_AGENT); }
__device__ __forceinline__ unsigned xb_add(unsigned* p, unsigned v) { return __hip_atomic_fetch_add(p, v, __ATOMIC_RELAXED, __HIP_MEMORY_SCOPE_AGENT); }
__device__ __forceinline__ unsigned xb_xcc_id() { return (unsigned)__builtin_amdgcn_s_getreg((3 << 11) | 20) & 0xFu; }
#define XB_SPIN(cond, bar) do { unsigned _sp = 0; while (cond) { __builtin_amdgcn_s_sleep(1); \
    if ((++_sp & 255u) == 0u) { if (xb_ld(&(bar)[XB_TMO])) break; if (_sp > XB_SPIN_CAP) { atomicAdd(&(bar)[XB_TMO], 1u); break; } } } } while (0)

struct XcdBarrier {
    unsigned* bar; unsigned x;
    volatile LAS unsigned* st;
};

__device__ __forceinline__ XcdBarrier xcd_barrier_post(unsigned* bar, volatile LAS unsigned* st) {
    XcdBarrier b; b.bar = bar; b.x = xb_xcc_id(); b.st = st;
    if (threadIdx.x == 0) (void)xb_add(&bar[XB_XCNT(b.x)], 1u);
    return b;
}
__device__ __forceinline__ void xcd_barrier_complete(unsigned* bar, unsigned x, unsigned& nloc, unsigned& nx) {
    const unsigned G = gridDim.x * gridDim.y * gridDim.z;
    unsigned sum, cnt, mine, sp = 0u;
    for (;;) {
        sum = 0u; cnt = 0u; mine = 0u;
#pragma unroll
        for (unsigned j = 0; j < 16; ++j) { const unsigned c = xb_ld(&bar[XB_XCNT(j)]); sum += c; cnt += (c > 0u) ? 1u : 0u; mine = (j == x) ? c : mine; }
        if (sum == G) break;
        __builtin_amdgcn_s_sleep(1);
        if ((++sp & 255u) == 0u) { if (xb_ld(&bar[XB_TMO])) break; if (sp > XB_SPIN_CAP) { atomicAdd(&bar[XB_TMO], 1u); break; } }
    }
    nloc = mine > 0u ? mine : 1u; nx = cnt > 0u ? cnt : 1u;
}

__device__ __forceinline__ void xcd_barrier(const XcdBarrier& b) {
    asm volatile("s_waitcnt vmcnt(0)" ::: "memory");
    __syncthreads();
    if (threadIdx.x == 0) {
        unsigned* bar = b.bar;
        __builtin_amdgcn_s_waitcnt(0);
        unsigned nloc = b.st[0], nx = b.st[1];
        if (nloc == 0u) { xcd_barrier_complete(bar, b.x, nloc, nx); b.st[0] = nloc; b.st[1] = nx; }
        const unsigned old = xb_add(&bar[XB_XSUB(b.x)], 1u);
        const unsigned gen = old / nloc;
        if (old + 1u == (gen + 1u) * nloc) {
            __builtin_amdgcn_fence(__ATOMIC_RELEASE, "agent");
            asm volatile("s_waitcnt vmcnt(0)" ::: "memory");
            const unsigned og = xb_add(&bar[XB_TOP], 1u);
            const unsigned tg = og / nx;
            if (og + 1u == (tg + 1u) * nx) xb_add(&bar[XB_TOPGEN], 1u);
            else XB_SPIN(xb_ld(&bar[XB_TOPGEN]) == tg, bar);
            __builtin_amdgcn_fence(__ATOMIC_ACQUIRE, "agent");
            xb_add(&bar[XB_XGEN(b.x)], 1u);
            asm volatile("s_waitcnt vmcnt(0)" ::: "memory");
        } else {
            XB_SPIN(xb_ld(&bar[XB_XGEN(b.x)]) == gen, bar);
            __builtin_amdgcn_fence(__ATOMIC_ACQUIRE, "agent");
            asm volatile("s_waitcnt vmcnt(0)" ::: "memory");
        }
    }
    __syncthreads();
}

__device__ __forceinline__ float wave_sum(float v) {
#pragma unroll
    for (int o = 1; o < 64; o <<= 1) v += __shfl_xor(v, o);
    return v;
}
__device__ __forceinline__ float bcat(const float* ba, const float* bkv, const float* bb, int n) { return n < MOD_KV ? ba[n] : (n < MOD_B ? bkv[n - MOD_KV] : bb[n - MOD_B]); }

__device__ __forceinline__ void p0_gemv(LAS unsigned char* lds, const float* c, const float* wa, const float* wkv, const float* wb, float* modp, int vcu, int G, int tid, int lane, int wave) {
    LAS float* SC = (LAS float*)lds;
    LAS float* RED = (LAS float*)(lds + 16384);
    for (int i = tid; i < D; i += NWAVES * 64) SC[i] = silu(c[i]);
    __syncthreads();
    for (int u = vcu; u < 256; u += G) {
        const int ch = u >> 1, kh = u & 1;
        const float* W; int pitch, col;
        if (ch < 48) { W = wa; pitch = 12288; col = ch * 256; } else if (ch < 80) { W = wkv; pitch = 8192; col = (ch - 48) * 256; } else { W = wb; pitch = 12288; col = (ch - 80) * 256; }
        const int k0 = kh * 2048 + wave * 256;
        const float* p = W + (size_t)k0 * pitch + col + 4 * lane;
        f32x4 a0 = {0.f, 0.f, 0.f, 0.f}, a1 = a0;
#pragma unroll 4
        for (int k = 0; k < 256; k += 2) {
            const f32x4 w0 = *(const f32x4*)(p + (size_t)k * pitch), w1 = *(const f32x4*)(p + (size_t)(k + 1) * pitch);
            a0 += w0 * SC[k0 + k]; a1 += w1 * SC[k0 + k + 1];
        }
        a0 += a1;
        *(LAS f32x4*)(RED + wave * 256 + 4 * lane) = a0;
        __syncthreads();
        if (tid < 256) { float s = 0.f;
#pragma unroll
            for (int w = 0; w < 8; ++w) s += RED[w * 256 + tid];
            modp[kh * NMOD + ch * 256 + tid] = s; }
        __syncthreads();
    }
}

template <int PERMUTE>
__device__ __forceinline__ void p0_transpose_item(const float* W, int N, bf16* WT, LAS unsigned short* T, int item, int lane) {
    const int nblk = N / 64, kb = item / nblk, nb = item % nblk, k0 = 64 * kb, n0 = 64 * nb;
    f32x4 v[16];
    const int kk0 = lane >> 4, nn = 4 * (lane & 15);
#pragma unroll
    for (int i = 0; i < 16; ++i) v[i] = *(const f32x4*)(W + (size_t)(k0 + 4 * i + kk0) * N + n0 + nn);
#pragma unroll
    for (int i = 0; i < 16; ++i) { const int kk = 4 * i + kk0;
        T[(nn + 0) * 72 + kk] = (unsigned short)f2bf(v[i][0]); T[(nn + 1) * 72 + kk] = (unsigned short)f2bf(v[i][1]);
        T[(nn + 2) * 72 + kk] = (unsigned short)f2bf(v[i][2]); T[(nn + 3) * 72 + kk] = (unsigned short)f2bf(v[i][3]); }
    LDS_WAIT(); asm volatile("" ::: "memory");
    const int c = lane & 7;
#pragma unroll
    for (int j = 0; j < 8; ++j) { const int n = (lane >> 3) + 8 * j;
        const v4u o = *(const LAS v4u*)(T + n * 72 + 8 * c);
        int nsrc = n0 + n, ndst = nsrc;
        if (PERMUTE) {
            const int q = nsrc >> 12, chn = nsrc & 4095;
            ndst = 256 * (chn >> 6) + 128 * (q >> 1) + 32 * ((chn >> 4) & 3) + 8 * ((chn >> 2) & 3) + 4 * (q & 1) + (chn & 3);
        }
        *(v4u*)(WT + (size_t)ndst * D + k0 + 8 * c) = o; }
    LDS_WAIT(); asm volatile("" ::: "memory");
}

template <int NOUT>
__device__ __forceinline__ void norm_rows_bf16(const float* X, bf16* O0, bf16* O1, const LAS float* GS, int gw, int NGW, int lane) {
    for (int m = gw; m < M; m += NGW) {
        asm volatile("" ::: "memory");
        const f32x4* xr = (const f32x4*)(X + (size_t)m * D) + lane;
        f32x4 v[16]; float s = 0.f;
#pragma unroll
        for (int j = 0; j < 16; ++j) { v[j] = xr[64 * j]; s += (v[j][0] * v[j][0] + v[j][1] * v[j][1]) + (v[j][2] * v[j][2] + v[j][3] * v[j][3]); }
        const float rstd = __builtin_amdgcn_rsqf(wave_sum(s) * (1.f / D) + EPS);
#pragma unroll
        for (int o = 0; o < NOUT; ++o) {
            v2u* op = (v2u*)((o == 0 ? O0 : O1) + (size_t)m * D) + lane;
#pragma unroll
            for (int j = 0; j < 16; ++j) {
                const f32x4 g4 = *(const LAS f32x4*)(GS + (o * 2 + 0) * D + 256 * j + 4 * lane), s4 = *(const LAS f32x4*)(GS + (o * 2 + 1) * D + 256 * j + 4 * lane);
                const f32x4 y = v[j] * rstd * g4 + s4;
                v2u w; w.x = pk2(y[0], y[1]); w.y = pk2(y[2], y[3]); op[64 * j] = w; }
        }
    }
}

__device__ __forceinline__ void convgate_naive(const bf16* P, const float* cw, bf16* Y, int gtid, int total) {
    for (size_t idx = (size_t)gtid; idx < (size_t)M * 512; idx += (size_t)total) {
        const int t = (int)(idx >> 9), j = (int)(idx & 511) * 8;
        const bf16* r0 = P + (size_t)t * 16384 + j;
        const v4u zero = {0u, 0u, 0u, 0u};
        const v4u bq = *(const v4u*)(r0), zq = *(const v4u*)(r0 + 12288);
        const v4u c0 = *(const v4u*)(r0 + 4096), u0 = *(const v4u*)(r0 + 8192);
        const v4u c1 = t >= 1 ? *(const v4u*)(r0 - 16384 + 4096) : zero, u1 = t >= 1 ? *(const v4u*)(r0 - 16384 + 8192) : zero;
        const v4u c2 = t >= 2 ? *(const v4u*)(r0 - 32768 + 4096) : zero, u2 = t >= 2 ? *(const v4u*)(r0 - 32768 + 8192) : zero;
        float w0[8], w1[8], w2[8];
#pragma unroll
        for (int e = 0; e < 8; e += 4) { const f32x4 a = *(const f32x4*)(cw + j + e), b = *(const f32x4*)(cw + D + j + e), c = *(const f32x4*)(cw + 2 * D + j + e);
#pragma unroll
            for (int i = 0; i < 4; ++i) { w0[e + i] = a[i]; w1[e + i] = b[i]; w2[e + i] = c[i]; } }
        v4u o;
#pragma unroll
        for (int e = 0; e < 4; ++e) {
            float y[2];
#pragma unroll
            for (int hh = 0; hh < 2; ++hh) {
                const float b = hh ? bfhi(bq[e]) : bflo(bq[e]), z = hh ? bfhi(zq[e]) : bflo(zq[e]);
                const float cu0 = (hh ? bfhi(c0[e]) : bflo(c0[e])) * (hh ? bfhi(u0[e]) : bflo(u0[e]));
                const float cu1 = (hh ? bfhi(c1[e]) : bflo(c1[e])) * (hh ? bfhi(u1[e]) : bflo(u1[e]));
                const float cu2 = (hh ? bfhi(c2[e]) : bflo(c2[e])) * (hh ? bfhi(u2[e]) : bflo(u2[e]));
                const int ee = 2 * e + hh;
                y[hh] = b * (w0[ee] * cu2 + w1[ee] * cu1 + w2[ee] * cu0) * silu(z);
            }
            o[e] = pk2(y[0], y[1]);
        }
        *(v4u*)(Y + (size_t)t * D + j) = o;
    }
}

__device__ __forceinline__ int t5_bucket(int d) { if (d < 16) return d; const int b = 16 + (int)(__log2f((float)d * 0.0625f) * (16.0f / 3.0f)); return b < 31 ? b : 31; }

__device__ __forceinline__ void attn_naive(LAS unsigned char* lds, const bf16* Q, const bf16* K, const bf16* V, const bf16* Z, bf16* O, const float* rel_bias, const float* sinks, int gtid, int total, int tid) {
    LAS float* BT = (LAS float*)lds;
    for (int i = tid; i < NH * WIN; i += NWAVES * 64) { const int h = i >> 7, d = i & 127; BT[i] = rel_bias[t5_bucket(d) * NH + h] * LOG2E; }
    __syncthreads();
    for (int idx = gtid; idx < M * NH; idx += total) {
        const int h = idx >> 14, t = idx & (M - 1), g = h >> 3;
        float q[64], acc[64];
        { const v4u* qp = (const v4u*)(Q + (size_t)t * D + h * 64);
#pragma unroll
          for (int c = 0; c < 8; ++c) { const v4u w = qp[c];
#pragma unroll
              for (int e = 0; e < 4; ++e) { q[8 * c + 2 * e] = bflo(w[e]); q[8 * c + 2 * e + 1] = bfhi(w[e]); } } }
#pragma unroll
        for (int d = 0; d < 64; ++d) acc[d] = 0.f;
        float mx = sinks[h] * LOG2E, l = 1.f;
        const int nd = t < WIN - 1 ? t : WIN - 1;
        for (int i = 0; i <= nd; ++i) {
            const int s = t - i;
            const v4u* kp = (const v4u*)(K + (size_t)s * KVD + g * 64);
            float dot = 0.f;
#pragma unroll
            for (int c = 0; c < 8; ++c) { const v4u w = kp[c];
#pragma unroll
                for (int e = 0; e < 4; ++e) { dot += q[8 * c + 2 * e] * bflo(w[e]); dot += q[8 * c + 2 * e + 1] * bfhi(w[e]); } }
            const float lg = dot + BT[h * WIN + i];
            const float mn = fmaxf(mx, lg), f = __builtin_amdgcn_exp2f(mx - mn), p = __builtin_amdgcn_exp2f(lg - mn);
            l = l * f + p; mx = mn;
            const v4u* vp = (const v4u*)(V + (size_t)s * KVD + g * 64);
#pragma unroll
            for (int c = 0; c < 8; ++c) { const v4u w = vp[c];
#pragma unroll
                for (int e = 0; e < 4; ++e) { acc[8 * c + 2 * e] = acc[8 * c + 2 * e] * f + p * bflo(w[e]); acc[8 * c + 2 * e + 1] = acc[8 * c + 2 * e + 1] * f + p * bfhi(w[e]); } }
        }
        const float inv = 1.0f / l;
        const v4u* zp = (const v4u*)(Z + (size_t)t * D + h * 64); v4u* op = (v4u*)(O + (size_t)t * D + h * 64);
#pragma unroll
        for (int c = 0; c < 8; ++c) { const v4u w = zp[c]; v4u o;
#pragma unroll
            for (int e = 0; e < 4; ++e) o[e] = pk2(acc[8 * c + 2 * e] * inv * bflo(w[e]), acc[8 * c + 2 * e + 1] * inv * bfhi(w[e]));
            op[c] = o; }
    }
}


__device__ __forceinline__ void conv_fixup(const float* BSH, const float* PCH, const float* CUH, const float* cw, bf16* Y, int gtid, int total) {
    for (int idx = gtid; idx < 63 * 2 * 1024; idx += total) {
        const int c4 = (idx & 1023) * 4, r = (idx >> 10) & 1, pm = (idx >> 11) + 1;
        const f32x4 bs = *(const f32x4*)(BSH + ((size_t)pm * 2 + r) * D + c4), pc = *(const f32x4*)(PCH + ((size_t)pm * 2 + r) * D + c4);
        const f32x4 w0 = *(const f32x4*)(cw + c4), w1 = *(const f32x4*)(cw + D + c4);
        const f32x4 cA = *(const f32x4*)(CUH + ((size_t)(pm - 1) * 2 + 0) * D + c4), cB = *(const f32x4*)(CUH + ((size_t)(pm - 1) * 2 + 1) * D + c4);
        const f32x4 extra = r == 0 ? w0 * cA + w1 * cB : w0 * cB;
        const f32x4 y = bs * (pc + extra);
        v2u w; w.x = pk2(y[0], y[1]); w.y = pk2(y[2], y[3]);
        *(v2u*)(Y + ((size_t)pm * 256 + r) * D + c4) = w;
    }
}

namespace swa {
typedef short bf16x8 __attribute__((ext_vector_type(8)));
typedef float f32x16 __attribute__((ext_vector_type(16)));
constexpr int KP = 144, VP = 520;
constexpr int LDS_K = 0, LDS_V = 256 * KP, LDS_BT = LDS_V + 64 * VP, LDS_END = LDS_BT + NH * WIN * 4;
static_assert(LDS_V % 16 == 0 && LDS_BT % 16 == 0 && LDS_END <= RING_BYTES, "attention LDS map");
__device__ __forceinline__ int crow(int r, int hi) { return (r & 3) + 8 * (r >> 2) + 4 * hi; }
__device__ __forceinline__ void attn_phase(LAS unsigned char* lds, const bf16* Q, const bf16* K, const bf16* V, const bf16* Z, bf16* O, const float* rel_bias, const float* sinks, int vcu, int G, int tid, int lane, int wave) {
    LAS float* BT = (LAS float*)(lds + LDS_BT);
    for (int i = tid; i < NH * WIN; i += NWAVES * 64) { const int h = i >> 7, d = i & 127; BT[i] = rel_bias[t5_bucket(d) * NH + h] * LOG2E; }
    const int al = lane & 31, hi = lane >> 5;
    LAS unsigned short* vt = (LAS unsigned short*)(lds + LDS_V);
    for (int u = vcu; u < (M / 128) * NKV; u += G) {
        const int qb = u >> 3, g = u & 7, h = 8 * g + wave;
        __syncthreads();
#pragma unroll
        for (int j = 0; j < 4; ++j) {
            const int idx = tid + NWAVES * 64 * j, key = idx >> 3, ch = idx & 7, pos = 128 * (qb - 1) + key;
            v4u kv = {0u, 0u, 0u, 0u}, vv = kv;
            if (pos >= 0) { kv = *(const v4u*)(K + (size_t)pos * KVD + g * 64 + ch * 8); vv = *(const v4u*)(V + (size_t)pos * KVD + g * 64 + ch * 8); }
            *(LAS v4u*)(lds + LDS_K + key * KP + ch * 16) = kv;
#pragma unroll
            for (int e = 0; e < 4; ++e) { vt[(ch * 8 + 2 * e) * (VP / 2) + key] = (unsigned short)(vv[e] & 0xffffu); vt[(ch * 8 + 2 * e + 1) * (VP / 2) + key] = (unsigned short)(vv[e] >> 16); }
        }
        __syncthreads();
        const float sink2 = sinks[h] * LOG2E;
        const LAS float* bt = BT + h * WIN;
        for (int i = 0; i < 4; ++i) {
            const int t0 = 128 * qb + 32 * i;
            bf16x8 qr[4];
            { const bf16* qp = Q + (size_t)(t0 + al) * D + h * 64 + 8 * hi;
#pragma unroll
              for (int s = 0; s < 4; ++s) qr[s] = *(const bf16x8*)(qp + 16 * s); }
            f32x16 S[5];
#pragma unroll
            for (int jj = 0; jj < 5; ++jj) {
                const LAS unsigned char* kp = lds + LDS_K + (32 * (i + jj) + al) * KP + hi * 16;
                f32x16 a = {0.f, 0.f, 0.f, 0.f, 0.f, 0.f, 0.f, 0.f, 0.f, 0.f, 0.f, 0.f, 0.f, 0.f, 0.f, 0.f};
#pragma unroll
                for (int s = 0; s < 4; ++s) { const bf16x8 kf = *(const LAS bf16x8*)(kp + s * 32); a = __builtin_amdgcn_mfma_f32_32x32x16_bf16(kf, qr[s], a, 0, 0, 0); }
                S[jj] = a;
            }
            float mx = sink2;
#pragma unroll
            for (int jj = 0; jj < 5; ++jj) {
#pragma unroll
                for (int r = 0; r < 16; ++r) {
                    const int kr = crow(r, hi), dist = 128 - 32 * jj + al - kr, b = 32 * (i + jj) + kr;
                    const bool inband = (jj >= 1 && jj <= 3) ? true : (dist >= 0 && dist < WIN);
                    const bool valid = inband && (qb > 0 || b >= 128);
                    const float v = valid ? S[jj][r] + bt[dist & (WIN - 1)] : -INFINITY;
                    S[jj][r] = v; mx = fmaxf(mx, v);
                }
                asm volatile("" ::: "memory");
            }
            mx = fmaxf(mx, __shfl_xor(mx, 32));
            float l = 0.f;
            v4u P[5][2];
#pragma unroll
            for (int jj = 0; jj < 5; ++jj)
#pragma unroll
                for (int ks = 0; ks < 2; ++ks)
#pragma unroll
                    for (int e = 0; e < 4; ++e) {
                        const float p0 = __builtin_amdgcn_exp2f(S[jj][8 * ks + 2 * e] - mx), p1 = __builtin_amdgcn_exp2f(S[jj][8 * ks + 2 * e + 1] - mx);
                        l += p0 + p1; P[jj][ks][e] = pg8::cvt_pk_bf16(p0, p1);
                    }
            l += __shfl_xor(l, 32);
            l += __builtin_amdgcn_exp2f(sink2 - mx);
            const float inv = 1.0f / l;
            f32x16 o[2];
            o[0] = (f32x16){0.f, 0.f, 0.f, 0.f, 0.f, 0.f, 0.f, 0.f, 0.f, 0.f, 0.f, 0.f, 0.f, 0.f, 0.f, 0.f}; o[1] = o[0];
#pragma unroll
            for (int jj = 0; jj < 5; ++jj)
#pragma unroll
                for (int ks = 0; ks < 2; ++ks) {
                    const bf16x8 pf = __builtin_bit_cast(bf16x8, P[jj][ks]);
                    const int kb = 32 * (i + jj) + 16 * ks + 4 * hi;
#pragma unroll
                    for (int db = 0; db < 2; ++db) {
                        const LAS unsigned char* vp = lds + LDS_V + (32 * db + al) * VP + kb * 2;
                        const v2u lo = *(const LAS v2u*)vp, hh = *(const LAS v2u*)(vp + 16);
                        const v4u vw = {lo.x, lo.y, hh.x, hh.y};
                        o[db] = __builtin_amdgcn_mfma_f32_32x32x16_bf16(__builtin_bit_cast(bf16x8, vw), pf, o[db], 0, 0, 0);
                    }
                }
#pragma unroll
            for (int db = 0; db < 2; ++db)
#pragma unroll
                for (int rq = 0; rq < 4; ++rq) {
                    const size_t off = (size_t)(t0 + al) * D + h * 64 + 32 * db + 8 * rq + 4 * hi;
                    const v2u zz = *(const v2u*)(Z + off);
                    v2u w; w.x = pk2(o[db][4 * rq] * inv * bflo(zz.x), o[db][4 * rq + 1] * inv * bfhi(zz.x)); w.y = pk2(o[db][4 * rq + 2] * inv * bflo(zz.y), o[db][4 * rq + 3] * inv * bfhi(zz.y));
                    *(v2u*)(O + off) = w;
                }
        }
    }
}
}

__device__ __forceinline__ void final_norm(float* X, const LAS float* G, int gw, int NGW, int lane) {
    for (int m = gw; m < M; m += NGW) {
        asm volatile("" ::: "memory");
        f32x4* xr = (f32x4*)(X + (size_t)m * D) + lane;
        f32x4 v[16]; float s = 0.f;
#pragma unroll
        for (int j = 0; j < 16; ++j) { v[j] = xr[64 * j]; s += (v[j][0] * v[j][0] + v[j][1] * v[j][1]) + (v[j][2] * v[j][2] + v[j][3] * v[j][3]); }
        const float rstd = __builtin_amdgcn_rsqf(wave_sum(s) * (1.f / D) + EPS);
#pragma unroll
        for (int j = 0; j < 16; ++j) xr[64 * j] = v[j] * rstd * *(const LAS f32x4*)(G + 256 * j + 4 * lane);
    }
}

struct Args { const float* in[20]; float* out; unsigned char* ws; int ph_lo, ph_hi; };
static_assert(sizeof(Args) == 22 * 8 + 8, "Args has no padding");
__global__ void __launch_bounds__(NWAVES * 64, 2) mk_fwd(Args args) {
    extern __shared__ __attribute__((aligned(16))) unsigned char lds_raw[];
    LAS unsigned char* lds = (LAS unsigned char*)lds_raw;
    volatile LAS unsigned* MISC = (volatile LAS unsigned*)(lds + MISC_OFF);
    const int tid = threadIdx.x, lane = tid & 63, wave = __builtin_amdgcn_readfirstlane(tid >> 6);
    const int G = gridDim.x; const int bx = blockIdx.x; const int vcu = (G % 8 == 0) ? (bx % 8) * (G / 8) + bx / 8 : bx;
    const int gw = vcu * NWAVES + wave, NGW = G * NWAVES, gtid = bx * (NWAVES * 64) + tid, gtotal = G * NWAVES * 64;
    unsigned char* ws = args.ws;
    gu32* ctl = (gu32*)(ws + WS_CTL);
    const float* x = args.in[0]; const float* cvec = args.in[1]; const float* g_a = args.in[2]; const float* w_mod_a = args.in[3]; const float* b_mod_a = args.in[4];
    const float* w_a_in = args.in[5]; const float* conv_a = args.in[6]; const float* w_a_out = args.in[7]; const float* g_kv = args.in[8]; const float* w_mod_kv = args.in[9];
    const float* b_mod_kv = args.in[10]; const float* w_kv = args.in[11]; const float* rel_bias = args.in[12]; const float* g_b = args.in[13]; const float* w_mod_b = args.in[14];
    const float* b_mod_b = args.in[15]; const float* w_b_in = args.in[16]; const float* sinks_b = args.in[17]; const float* w_b_out = args.in[18]; const float* g_final = args.in[19];
    float* out = args.out;
    float* modp = (float*)(ws + WS_MODP); float* modv = (float*)(ws + WS_MODV);
    bf16* W_AIN = (bf16*)(ws + WS_WAIN); bf16* W_AOUT = (bf16*)(ws + WS_WAOUT); bf16* W_KV = (bf16*)(ws + WS_WKV); bf16* W_BIN = (bf16*)(ws + WS_WBIN); bf16* W_BOUT = (bf16*)(ws + WS_WBOUT);
    bf16* HA = (bf16*)(ws + WS_HA); bf16* YB = (bf16*)(ws + WS_Y); float* X1 = (float*)(ws + WS_X1); bf16* PROJ = (bf16*)(ws + WS_BIG);
    float* CUH = (float*)(ws + WS_HALO); float* BSH = (float*)(ws + WS_HALO + 2 * MiB); float* PCH = (float*)(ws + WS_HALO + 4 * MiB);
    bf16* QB = (bf16*)(ws + WS_Q); bf16* ZB = (bf16*)(ws + WS_Z); bf16* AG = (bf16*)(ws + WS_AG); bf16* KB = (bf16*)(ws + WS_K); bf16* VB = (bf16*)(ws + WS_V);

    for (int u = tid; u < (LDS_BYTES - LDSCTL_OFF) / 4; u += NWAVES * 64) ((LAS unsigned*)(lds + LDSCTL_OFF))[u] = 0u;
    __syncthreads();
    XcdBarrier bar; bar.bar = (unsigned*)(ctl + CW_BAR); bar.x = 0; bar.st = nullptr;
    if (N_LAUNCHES == 1) bar = xcd_barrier_post((unsigned*)(ctl + CW_BAR), MISC + 8);
#define GRID_BAR(seam) do { if (N_LAUNCHES != 1) { if (tid == 0) __hip_atomic_store(ctl + CW_TMO, 0xBADBA0u | (unsigned)(seam), RLX_AGENT); } else { xcd_barrier(bar); } } while (0)
    const int lo = args.ph_lo, hi = args.ph_hi;
#define IN(k) (lo <= (k) && (k) < hi)
#define BOTH(k) (IN(k) && IN((k) + 1))

    if (IN(0)) {
        p0_gemv(lds, cvec, w_mod_a, w_mod_kv, w_mod_b, modp, vcu, G, tid, lane, wave);
        LAS unsigned short* T = (LAS unsigned short*)(lds + wave * 9216);
        constexpr int I_AIN = 64 * 256, I_AOUT = 64 * 64, I_KV = 64 * 16, I_BIN = 64 * 128, I_BOUT = 64 * 64, NITEMS = I_AIN + I_AOUT + I_KV + I_BIN + I_BOUT;
        for (int it = gw; it < NITEMS; it += NGW) {
            int r = it;
            if (r < I_AIN) { p0_transpose_item<USE_FUSED_CONV>(w_a_in, 16384, W_AIN, T, r, lane); continue; } r -= I_AIN;
            if (r < I_AOUT) { p0_transpose_item<0>(w_a_out, 4096, W_AOUT, T, r, lane); continue; } r -= I_AOUT;
            if (r < I_KV) { p0_transpose_item<0>(w_kv, 1024, W_KV, T, r, lane); continue; } r -= I_KV;
            if (r < I_BIN) { p0_transpose_item<0>(w_b_in, 8192, W_BIN, T, r, lane); continue; } r -= I_BIN;
            p0_transpose_item<0>(w_b_out, 4096, W_BOUT, T, r, lane);
        }
        if (BOTH(0)) GRID_BAR(0);
    }
    if (IN(1)) {
        LAS float* GS = (LAS float*)lds;
        for (int i = tid; i < D; i += NWAVES * 64) {
            const float sh = b_mod_a[i] + modp[MOD_A + i] + modp[NMOD + MOD_A + i];
            const float sc = b_mod_a[D + i] + modp[MOD_A + D + i] + modp[NMOD + MOD_A + D + i];
            GS[i] = g_a[i] * (1.0f + sc); GS[D + i] = sh; }
        for (int n = gtid; n < NMOD; n += gtotal) modv[n] = bcat(b_mod_a, b_mod_kv, b_mod_b, n) + modp[n] + modp[NMOD + n];
        __syncthreads();
        norm_rows_bf16<1>(x, HA, nullptr, GS, gw, NGW, lane);
        __syncthreads();
        if (BOTH(1)) GRID_BAR(1);
    }
    if (IN(2)) {
        pg8::Gemm g{HA, W_AIN, M, 4 * D, D}; pg8::StaticOrder S; S.init(M, 4 * D, G, bx);
#if USE_FUSED_CONV
        pg8::EpiConvGate E{YB, conv_a, CUH, BSH, PCH, (LAS float*)(lds + XCH_OFF)};
        pg8::gemm_phase<pg8::EpiConvGate, pg8::StaticOrder, true, true>(lds + RING_OFF, g, S, E);
#else
        pg8::EpiBf16S E{PROJ, 4 * D, 0, 0, 1.f, 0};
        pg8::gemm_phase<pg8::EpiBf16S, pg8::StaticOrder, true, true>(lds + RING_OFF, g, S, E);
#endif
        if (BOTH(2)) GRID_BAR(2);
    }
    if (IN(3)) {
#if USE_FUSED_CONV
        conv_fixup(BSH, PCH, CUH, conv_a, YB, gtid, gtotal);
#else
        convgate_naive(PROJ, conv_a, YB, gtid, gtotal);
#endif
        if (BOTH(3)) GRID_BAR(3);
    }
    if (IN(4)) {
        pg8::Gemm g{YB, W_AOUT, M, D, D}; pg8::StaticOrder S; S.init(M, D, G, bx);
        pg8::EpiResGate E{x, X1, D, modv + MOD_A + 2 * D};
        pg8::gemm_phase<pg8::EpiResGate, pg8::StaticOrder, true, true>(lds + RING_OFF, g, S, E);
        if (BOTH(4)) GRID_BAR(4);
    }
    if (IN(5)) {
        LAS float* GS = (LAS float*)lds;
        for (int i = tid; i < D; i += NWAVES * 64) {
            GS[i] = g_kv[i] * (1.0f + modv[MOD_KV + D + i]); GS[D + i] = modv[MOD_KV + i];
            GS[2 * D + i] = g_b[i] * (1.0f + modv[MOD_B + D + i]); GS[3 * D + i] = modv[MOD_B + i]; }
        __syncthreads();
        norm_rows_bf16<2>(X1, HA, YB, GS, gw, NGW, lane);
        __syncthreads();
        if (BOTH(5)) GRID_BAR(5);
    }
    if (IN(6)) {
        { pg8::Gemm g{HA, W_KV, M, 2 * KVD, D}; pg8::StaticOrder S; S.init(M, 2 * KVD, G, bx);
          pg8::EpiBf16S E{KB, KVD, KVD, (size_t)(WS_V - WS_K) / 2, 1.f, 0};
          pg8::gemm_phase<pg8::EpiBf16S, pg8::StaticOrder, true, true>(lds + RING_OFF, g, S, E); }
        { pg8::Gemm g{YB, W_BIN, M, 2 * D, D}; pg8::StaticOrder S; S.init(M, 2 * D, G, bx);
          pg8::EpiBf16S E{QB, D, D, (size_t)(WS_Z - WS_Q) / 2, QSCALE, 1};
          pg8::gemm_phase<pg8::EpiBf16S, pg8::StaticOrder, true, true>(lds + RING_OFF, g, S, E); }
        if (BOTH(6)) GRID_BAR(6);
    }
    if (IN(7)) {
#if USE_MFMA_ATTN
        swa::attn_phase(lds, QB, KB, VB, ZB, AG, rel_bias, sinks_b, vcu, G, tid, lane, wave);
#else
        attn_naive(lds, QB, KB, VB, ZB, AG, rel_bias, sinks_b, gtid, gtotal, tid);
#endif
        __syncthreads();
        if (BOTH(7)) GRID_BAR(7);
    }
    if (IN(8)) {
        pg8::Gemm g{AG, W_BOUT, M, D, D}; pg8::StaticOrder S; S.init(M, D, G, bx);
        pg8::EpiResGate E{X1, out, D, modv + MOD_B + 2 * D};
        pg8::gemm_phase<pg8::EpiResGate, pg8::StaticOrder, true, true>(lds + RING_OFF, g, S, E);
        if (BOTH(8)) GRID_BAR(8);
    }
    if (IN(9)) {
        LAS float* GF = (LAS float*)lds;
        for (int i = tid; i < D; i += NWAVES * 64) GF[i] = g_final[i];
        __syncthreads();
        final_norm(out, GF, gw, NGW, lane);
    }
#undef IN
#undef BOTH
}

extern "C" void kernel_launch(void* const* d_in, const int* in_sizes, int n_in, void* d_out, int out_size, void* d_ws, size_t ws_size, hipStream_t stream) {
    static int grid = 0;
    if (grid == 0) {
        if (n_in != 20 || in_sizes[0] != M * D || out_size != M * D || ws_size < WS_END) { fprintf(stderr, "kernel_launch: built for 20 inputs, x/out of %d floats, >= %zu bytes of workspace; got n_in %d, in0 %d, out %d, ws %zu; nothing launched\n", M * D, (size_t)WS_END, n_in, n_in > 0 ? in_sizes[0] : -1, out_size, ws_size); grid = -1; return; }
        int dev = 0, cus = 0, per_cu = 0;
        if (hipGetDevice(&dev) != hipSuccess || hipDeviceGetAttribute(&cus, hipDeviceAttributeMultiprocessorCount, dev) != hipSuccess) { fprintf(stderr, "kernel_launch: hipGetDevice / hipDeviceGetAttribute failed\n"); grid = -1; return; }
        if (hipFuncSetAttribute((const void*)mk_fwd, hipFuncAttributeMaxDynamicSharedMemorySize, LDS_BYTES) != hipSuccess) { fprintf(stderr, "kernel_launch: hipFuncSetAttribute failed\n"); grid = -1; return; }
        if (hipOccupancyMaxActiveBlocksPerMultiprocessor(&per_cu, (const void*)mk_fwd, NWAVES * 64, LDS_BYTES) != hipSuccess || per_cu < 1)
            fprintf(stderr, "kernel_launch: note: the occupancy query reports %d workgroups per CU\n", per_cu);
        (void)hipGetLastError();
        grid = cus;
    }
    if (grid < 0) return;
    if (hipMemsetAsync((char*)d_ws + WS_CTL, 0, CTL_ZERO_BYTES, stream) != hipSuccess) { fprintf(stderr, "kernel_launch: hipMemsetAsync failed\n"); return; }
    Args a{};
    for (int i = 0; i < 20; ++i) a.in[i] = (const float*)d_in[i];
    a.out = (float*)d_out; a.ws = (unsigned char*)d_ws;
    for (int li = 0; li < N_LAUNCHES; ++li) {
        a.ph_lo = (N_LAUNCHES == 1) ? 0 : li; a.ph_hi = (N_LAUNCHES == 1) ? NPH : li + 1;
        hipLaunchKernelGGL(mk_fwd, dim3(grid), dim3(NWAVES * 64), LDS_BYTES, stream, a);
        const hipError_t le = hipPeekAtLastError();
        if (le != hipSuccess) { fprintf(stderr, "kernel_launch: launch %d failed: %s\n", li, hipGetErrorName(le)); break; }
    }
}
```

```cpp
#include <hip/hip_runtime.h>
#include <cstdio>
#include <cstdint>
namespace pg8 {
#define PG8_LAS __attribute__((address_space(3)))
typedef unsigned short bf16_t;
typedef short bf16x8 __attribute__((ext_vector_type(8)));
typedef float f32x4 __attribute__((ext_vector_type(4)));
typedef unsigned u32x4 __attribute__((ext_vector_type(4)));
constexpr int BM = 256, BK = 64, HALF = 128, HTB = HALF * BK * 2  , STAGE_BYTES = 8 * HTB, NXCD = 8, WGM = 8;

__host__ __device__ __forceinline__ int lds_byte(int r, int c) { const int st = (r >> 4) * 2 + (c >> 5), rr = r & 15, cc = c & 31, ob = rr * 64 + cc * 2; return st * 1024 + (ob ^ (((ob >> 9) & 1) << 5)); }
__host__ __device__ __forceinline__ void stage_rc(int b, int& R, int& C) { const int st = b / 1024, sb = b % 1024, swz = sb ^ (((sb >> 9) & 1) << 5); R = (st >> 1) * 16 + swz / 64; C = (st & 1) * 32 + (swz % 64) / 2; }
__host__ __device__ __forceinline__ int perm32(int rho) { const int n = rho >> 4, i = rho & 15; return 8 * (i >> 2) + 4 * n + (i & 3); }

struct Unit { int pm, pn; };
struct Gemm { const bf16_t* A; const bf16_t* Bt; int M, N, K; };

struct StaticOrder {
    int nM, nN, nwg, G, c;
    __host__ __device__ void init(int M, int N, int G_, int c_) { nM = M / BM; nN = N / BM; nwg = nM * nN; G = G_; c = c_; }
    __host__ __device__ bool next(int i, Unit& u) const {
        const long L = (long)i * G + c; if (L >= nwg) return false;
        int wgid = (int)L; { const int q = nwg / NXCD, r = nwg % NXCD, xcd = wgid % NXCD, off = wgid / NXCD; wgid = (xcd < r ? xcd * (q + 1) : r * (q + 1) + (xcd - r) * q) + off; }
        const int nig = WGM * nN, gid = wgid / nig, fm = gid * WGM, gsz = (nM - fm) < WGM ? (nM - fm) : WGM;
        u.pm = fm + ((wgid % nig) % gsz); u.pn = (wgid % nig) / gsz; return true;
    }
    __device__ __forceinline__ void a_ready(const Unit&) const {}
    __device__ __forceinline__ void done(const Unit&) const {}
};
__device__ __forceinline__ unsigned cvt_pk_bf16(float lo, float hi) { unsigned r; asm volatile("v_cvt_pk_bf16_f32 %0, %1, %2" : "=v"(r) : "v"(lo), "v"(hi)); return r; }
__device__ __forceinline__ float silu_f(float v) { return v * __builtin_amdgcn_rcpf(1.0f + __expf(-v)); }

struct EpiBf16S {
    static constexpr bool PERM = true, AFTER_DRAIN = false;
    bf16_t* O; int ldc; int split_cols; size_t split_stride; float scale0; int silu1; float pre;
    __device__ __forceinline__ void operator()(const f32x4 (&acc)[2][2][4][2], const Unit& u, int wr, int wc, int fr, int fq) const {
        const int row0 = u.pm * BM + wr * 64 + fr; int colt = u.pn * BM; bf16_t* base = O;
        float sc = 1.f; bool act = false;
        if (split_cols) { const int t = colt / split_cols; base += (size_t)t * split_stride; colt -= t * split_cols; if (t == 0) sc = scale0; else act = (silu1 != 0); }
        const int col0 = colt + wc * 32 + 8 * fq;
#pragma unroll
        for (int ai = 0; ai < 2; ++ai)
#pragma unroll
            for (int m = 0; m < 4; ++m) { bf16_t* rowp = base + (size_t)(row0 + ai * HALF + m * 16) * ldc + col0;
#pragma unroll
                for (int bj = 0; bj < 2; ++bj) { f32x4 v0 = acc[ai][bj][m][0] * pre, v1 = acc[ai][bj][m][1] * pre;
                    if (act) { v0 = (f32x4){silu_f(v0[0]), silu_f(v0[1]), silu_f(v0[2]), silu_f(v0[3])}; v1 = (f32x4){silu_f(v1[0]), silu_f(v1[1]), silu_f(v1[2]), silu_f(v1[3])}; }
                    v0 = v0 * sc; v1 = v1 * sc; u32x4 w; w.x = cvt_pk_bf16(v0[0], v0[1]); w.y = cvt_pk_bf16(v0[2], v0[3]); w.z = cvt_pk_bf16(v1[0], v1[1]); w.w = cvt_pk_bf16(v1[2], v1[3]);
                    *(u32x4*)(rowp + bj * HALF) = w; } }
    }
};

struct EpiResGate {
    static constexpr bool PERM = false, AFTER_DRAIN = false;
    const float* base; float* out; int ldc; const float* gate; float gmul;
    __device__ __forceinline__ void operator()(const f32x4 (&acc)[2][2][4][2], const Unit& u, int wr, int wc, int fr, int fq) const {
        const int col0 = u.pn * BM + wc * 32 + 4 * fq;
        f32x4 gv[2][2];
#pragma unroll
        for (int bj = 0; bj < 2; ++bj)
#pragma unroll
            for (int n = 0; n < 2; ++n) gv[bj][n] = *(const f32x4*)(gate + col0 + bj * HALF + n * 16) * gmul;
#pragma unroll
        for (int ai = 0; ai < 2; ++ai)
#pragma unroll
            for (int m = 0; m < 4; ++m) { const size_t off = (size_t)(u.pm * BM + ai * HALF + wr * 64 + m * 16 + fr) * ldc + col0;
#pragma unroll
                for (int bj = 0; bj < 2; ++bj)
#pragma unroll
                    for (int n = 0; n < 2; ++n) { const f32x4 bs = *(const f32x4*)(base + off + bj * HALF + n * 16);
                        *(f32x4*)(out + off + bj * HALF + n * 16) = bs + gv[bj][n] * acc[ai][bj][m][n]; }
                if (m & 1) asm volatile("" ::: "memory"); }
    }
};

template <int N> __device__ __forceinline__ float row_shr1(float v) { return __builtin_bit_cast(float, __builtin_amdgcn_update_dpp(0, __builtin_bit_cast(int, v), 0x110 + N, 0xf, 0xf, true)); }
template <int N> __device__ __forceinline__ f32x4 row_shr4(f32x4 v) {
    const float a = row_shr1<N>(v[0]), b = row_shr1<N>(v[1]), c = row_shr1<N>(v[2]), d = row_shr1<N>(v[3]);
    return (f32x4){a, b, c, d};
}
struct EpiConvGate {
    static constexpr bool PERM = true, AFTER_DRAIN = false;
    bf16_t* Y; const float* cw; float* CUH; float* BSH; float* PCH; PG8_LAS float* XCH;
    __device__ __forceinline__ void operator()(const f32x4 (&acc)[2][2][4][2], const Unit& u, int wr, int wc, int fr, int fq) const {
        const int chl = 16 * wc + 4 * fq, ch0 = 64 * u.pn + chl;
        f32x4 cu[2][4];
#pragma unroll
        for (int ai = 0; ai < 2; ++ai)
#pragma unroll
            for (int m = 0; m < 4; ++m) cu[ai][m] = acc[ai][0][m][1] * acc[ai][1][m][0];
        if (fr >= 14) {
#pragma unroll
            for (int ai = 0; ai < 2; ++ai)
#pragma unroll
                for (int m = 0; m < 4; ++m) *(PG8_LAS f32x4*)(XCH + ((8 * ai + 4 * wr + m) * 2 + (fr - 14)) * 64 + chl) = cu[ai][m];
            if (wr == 1) *(f32x4*)(CUH + ((size_t)u.pm * 2 + (fr - 14)) * 4096 + ch0) = cu[1][3];
        }
        const f32x4 w0 = *(const f32x4*)(cw + ch0), w1 = *(const f32x4*)(cw + 4096 + ch0), w2 = *(const f32x4*)(cw + 8192 + ch0);
        asm volatile("s_waitcnt lgkmcnt(0)" ::: "memory"); __builtin_amdgcn_s_barrier(); asm volatile("" ::: "memory");
#pragma unroll
        for (int ai = 0; ai < 2; ++ai)
#pragma unroll
            for (int m = 0; m < 4; ++m) {
                const int gi = 8 * ai + 4 * wr + m;
                f32x4 h0 = {0.f, 0.f, 0.f, 0.f}, h1 = h0;
                if (gi > 0 && fr < 2) { h0 = *(const PG8_LAS f32x4*)(XCH + ((gi - 1) * 2 + 0) * 64 + chl); h1 = *(const PG8_LAS f32x4*)(XCH + ((gi - 1) * 2 + 1) * 64 + chl); }
                f32x4 p1 = row_shr4<1>(cu[ai][m]), p2 = row_shr4<2>(cu[ai][m]);
                if (fr == 0) { p1 = h1; p2 = h0; } else if (fr == 1) { p2 = h1; }
                const f32x4 conv = w0 * p2 + w1 * p1 + w2 * cu[ai][m];
                const f32x4 b = acc[ai][0][m][0], z = acc[ai][1][m][1];
                const f32x4 bs = {b[0] * silu_f(z[0]), b[1] * silu_f(z[1]), b[2] * silu_f(z[2]), b[3] * silu_f(z[3])};
                const f32x4 y = bs * conv;
                const size_t row = (size_t)u.pm * BM + ai * HALF + wr * 64 + m * 16 + fr;
                typedef unsigned u32x2 __attribute__((ext_vector_type(2)));
                u32x2 w; w.x = cvt_pk_bf16(y[0], y[1]); w.y = cvt_pk_bf16(y[2], y[3]);
                *(u32x2*)(Y + row * 4096 + ch0) = w;
                if (gi == 0 && fr < 2) { *(f32x4*)(BSH + ((size_t)u.pm * 2 + fr) * 4096 + ch0) = bs; *(f32x4*)(PCH + ((size_t)u.pm * 2 + fr) * 4096 + ch0) = conv; }
            }
    }
};

template <class Epi, class Sched, bool ALIGN_EPI = false, bool SP2 = false, bool FP8 = false>
__device__ __forceinline__ void gemm_phase(PG8_LAS unsigned char* lds, const Gemm g, const Sched& S, const Epi& E) {
    const int tid = threadIdx.x, wid = __builtin_amdgcn_readfirstlane(tid >> 6), lane = tid & 63, wr = wid >> 2, wc = wid & 3, fr = lane & 15, fq = lane >> 4;
    const int K = g.K, nt = K / BK;
    unsigned voffA[2], voffB[2];
#pragma unroll
    for (int i = 0; i < 2; ++i) { int R, C; stage_rc(tid * 16 + i * 8192, R, C); const int Rb = Epi::PERM ? ((R & ~31) + perm32(R & 31)) : R;
        voffA[i] = (unsigned)(R * K + C) * 2u; voffB[i] = (unsigned)(Rb * K + C) * 2u; }
    const size_t kstep = (size_t)(BK * 2);
    const size_t hstep = (size_t)HALF * K * 2;
    const size_t tstep = 2 * hstep;
    const unsigned ldsw = (unsigned)wid * 1024u;
    const int aoff = lds_byte(wr * 64 + fr, fq * 8), boff = lds_byte(wc * 32 + fr, fq * 8);
#define PG8_SA(b, h) (((b) * 2 + (h)) * HTB)
#define PG8_SB(b, h) ((4 + (b) * 2 + (h)) * HTB)
#define PG8_STAGE(bufoff, gbase, voff) do { _Pragma("unroll") for (int _i = 0; _i < 2; ++_i) \
        __builtin_amdgcn_global_load_lds((const unsigned*)((const char*)(gbase) + (voff)[_i]), (PG8_LAS unsigned*)(lds + (bufoff) + ldsw + _i * 8192), 16, 0, 0); } while (0)
#define PG8_LD16(off) (*(const PG8_LAS bf16x8*)(lds + (off)))
#define PG8_CAT8(x, y) __builtin_shufflevector(__builtin_bit_cast(pg8_v4i, (x)), __builtin_bit_cast(pg8_v4i, (y)), 0, 1, 2, 3, 4, 5, 6, 7)
#define PG8_LDA(dst, b, h) do { if constexpr (FP8) { _Pragma("unroll") for (int m = 0; m < 4; ++m) dst##8[m] = PG8_CAT8(PG8_LD16(PG8_SA(b, h) + aoff + m * 2048), PG8_LD16(PG8_SA(b, h) + aoff + m * 2048 + 1024)); } \
        else { _Pragma("unroll") for (int m = 0; m < 4; ++m) _Pragma("unroll") for (int k = 0; k < 2; ++k) dst[m][k] = PG8_LD16(PG8_SA(b, h) + aoff + m * 2048 + k * 1024); } } while (0)
#define PG8_LDB(dst, b, h) do { if constexpr (FP8) { _Pragma("unroll") for (int n = 0; n < 2; ++n) dst##8[n] = PG8_CAT8(PG8_LD16(PG8_SB(b, h) + boff + n * 2048), PG8_LD16(PG8_SB(b, h) + boff + n * 2048 + 1024)); } \
        else { _Pragma("unroll") for (int n = 0; n < 2; ++n) _Pragma("unroll") for (int k = 0; k < 2; ++k) dst[n][k] = PG8_LD16(PG8_SB(b, h) + boff + n * 2048 + k * 1024); } } while (0)
#define PG8_MMA(ai, bj, At, Bt) do { __builtin_amdgcn_s_setprio(1); \
        if constexpr (FP8) { _Pragma("unroll") for (int m = 0; m < 4; ++m) _Pragma("unroll") for (int n = 0; n < 2; ++n) \
                asm volatile("v_mfma_scale_f32_16x16x128_f8f6f4 %0, %1, %2, %0, %3, %3 op_sel_hi:[0,0,0]" : "+v"(acc[ai][bj][m][n]) : "v"(Bt##8[n]), "v"(At##8[m]), "v"(pg8_one)); } \
        else { _Pragma("unroll") for (int m = 0; m < 4; ++m) _Pragma("unroll") for (int n = 0; n < 2; ++n) _Pragma("unroll") for (int k = 0; k < 2; ++k) \
        acc[ai][bj][m][n] = __builtin_amdgcn_mfma_f32_16x16x32_bf16(Bt[n][k], At[m][k], acc[ai][bj][m][n], 0, 0, 0); } __builtin_amdgcn_s_setprio(0); } while (0)
#define PG8_WAIT_V(n) asm volatile("s_waitcnt vmcnt(" #n ")" ::: "memory")
#define PG8_WAIT_L(n) asm volatile("s_waitcnt lgkmcnt(" #n ")" ::: "memory")
#define PG8_BAR __builtin_amdgcn_s_barrier()
#define PG8_SCHED __builtin_amdgcn_sched_barrier(0)
    Unit cur, nxt; int ui = 0;
    if (!S.next(0, cur)) return;
    f32x4 acc[2][2][4][2];
#pragma unroll
    for (int a = 0; a < 2; ++a)
#pragma unroll
        for (int b = 0; b < 2; ++b)
#pragma unroll
            for (int m = 0; m < 4; ++m)
#pragma unroll
                for (int n = 0; n < 2; ++n) acc[a][b][m][n] = (f32x4){0.f, 0.f, 0.f, 0.f};
    typedef int pg8_v8i __attribute__((ext_vector_type(8))); typedef int pg8_v4i __attribute__((ext_vector_type(4)));
    const int pg8_one = 0x7F7F7F7F;
    bf16x8 At[4][2], B0[2][2], B1[2][2]; pg8_v8i At8[4], B08[2], B18[2];
    const char* cA = (const char*)g.A + (size_t)cur.pm * tstep; const char* cB = (const char*)g.Bt + (size_t)cur.pn * tstep;
    S.a_ready(cur);
    if constexpr (SP2) {
        PG8_STAGE(PG8_SB(0, 0), cB, voffB); PG8_STAGE(PG8_SB(0, 1), cB + hstep, voffB); PG8_STAGE(PG8_SA(0, 0), cA, voffA); PG8_STAGE(PG8_SA(0, 1), cA + hstep, voffA);
        if (wr == 1) PG8_BAR;
        PG8_WAIT_V(2); PG8_BAR;
        PG8_STAGE(PG8_SB(1, 0), cB + kstep, voffB); PG8_STAGE(PG8_SA(1, 0), cA + kstep, voffA); PG8_STAGE(PG8_SB(1, 1), cB + hstep + kstep, voffB);
        PG8_WAIT_V(6); PG8_BAR;
    } else {
        PG8_STAGE(PG8_SB(0, 0), cB, voffB); PG8_STAGE(PG8_SA(0, 0), cA, voffA); PG8_STAGE(PG8_SB(0, 1), cB + hstep, voffB); PG8_STAGE(PG8_SA(0, 1), cA + hstep, voffA);
        if (wr == 1) PG8_BAR;
        PG8_WAIT_V(4); PG8_BAR;
        PG8_STAGE(PG8_SB(1, 0), cB + kstep, voffB); PG8_STAGE(PG8_SA(1, 0), cA + kstep, voffA); PG8_STAGE(PG8_SB(1, 1), cB + hstep + kstep, voffB);
        PG8_WAIT_V(6); PG8_BAR;
    }
    for (;;) {
        const bool has_next = S.next(ui + 1, nxt);
        const char* nA = has_next ? (const char*)g.A + (size_t)nxt.pm * tstep : cA; const char* nB = has_next ? (const char*)g.Bt + (size_t)nxt.pn * tstep : cB;
        for (int t = 0; t < nt; t += 2) {
            const bool last = (t == nt - 2);
            const char* a1 = cA + (size_t)(t + 1) * kstep;
            const char* a2 = last ? nA : cA + (size_t)(t + 2) * kstep; const char* b2 = last ? nB : cB + (size_t)(t + 2) * kstep;
            const char* a3 = a2 + kstep; const char* b3 = b2 + kstep;
            if (last && has_next) S.a_ready(nxt);
            if constexpr (SP2) {
            PG8_LDB(B0, 0, 0); PG8_LDB(B1, 0, 1); PG8_SCHED; PG8_LDA(At, 0, 0); PG8_STAGE(PG8_SA(1, 1), a1 + hstep, voffA);
            PG8_WAIT_V(8); PG8_WAIT_L(0); PG8_BAR; PG8_MMA(0, 0, At, B0); PG8_MMA(0, 1, At, B1); PG8_BAR; PG8_SCHED;
            PG8_LDA(At, 0, 1); PG8_STAGE(PG8_SB(0, 0), b2, voffB); PG8_STAGE(PG8_SB(0, 1), b2 + hstep, voffB); PG8_STAGE(PG8_SA(0, 0), a2, voffA);
            PG8_WAIT_V(8); PG8_WAIT_L(0); PG8_BAR; PG8_MMA(1, 0, At, B0); PG8_MMA(1, 1, At, B1); PG8_BAR; PG8_SCHED;
            PG8_LDB(B0, 1, 0); PG8_LDB(B1, 1, 1); PG8_SCHED; PG8_LDA(At, 1, 0); PG8_STAGE(PG8_SA(0, 1), a2 + hstep, voffA);
            PG8_WAIT_V(8); PG8_WAIT_L(0); PG8_BAR; PG8_MMA(0, 0, At, B0); PG8_MMA(0, 1, At, B1); PG8_BAR; PG8_SCHED;
            PG8_LDA(At, 1, 1); PG8_STAGE(PG8_SB(1, 0), b3, voffB); PG8_STAGE(PG8_SB(1, 1), b3 + hstep, voffB); PG8_STAGE(PG8_SA(1, 0), a3, voffA);
            PG8_WAIT_V(8); PG8_WAIT_L(0); PG8_BAR; PG8_MMA(1, 0, At, B0); PG8_MMA(1, 1, At, B1); PG8_BAR; PG8_SCHED;
            } else {
            PG8_LDB(B0, 0, 0); PG8_SCHED; PG8_LDA(At, 0, 0); PG8_STAGE(PG8_SA(1, 1), a1 + hstep, voffA);
            PG8_WAIT_L(8); PG8_BAR; PG8_WAIT_L(0); PG8_MMA(0, 0, At, B0); PG8_BAR; PG8_SCHED;
            PG8_LDB(B1, 0, 1); PG8_STAGE(PG8_SB(0, 0), b2, voffB);
            PG8_BAR; PG8_WAIT_L(0); PG8_MMA(0, 1, At, B1); PG8_BAR;
            PG8_LDA(At, 0, 1); PG8_STAGE(PG8_SA(0, 0), a2, voffA);
            PG8_BAR; PG8_WAIT_L(0); PG8_MMA(1, 0, At, B0); PG8_BAR; PG8_SCHED;
            PG8_STAGE(PG8_SB(0, 1), b2 + hstep, voffB);
            PG8_WAIT_V(6); PG8_BAR; PG8_MMA(1, 1, At, B1); PG8_BAR;
            PG8_LDB(B0, 1, 0); PG8_SCHED; PG8_LDA(At, 1, 0); PG8_STAGE(PG8_SA(0, 1), a2 + hstep, voffA);
            PG8_WAIT_L(8); PG8_BAR; PG8_WAIT_L(0); PG8_MMA(0, 0, At, B0); PG8_BAR; PG8_SCHED;
            PG8_LDB(B1, 1, 1); PG8_STAGE(PG8_SB(1, 0), b3, voffB);
            PG8_BAR; PG8_WAIT_L(0); PG8_MMA(0, 1, At, B1); PG8_BAR;
            PG8_LDA(At, 1, 1); PG8_STAGE(PG8_SA(1, 0), a3, voffA);
            PG8_BAR; PG8_WAIT_L(0); PG8_MMA(1, 0, At, B0); PG8_BAR; PG8_SCHED;
            PG8_STAGE(PG8_SB(1, 1), b3 + hstep, voffB);
            PG8_WAIT_V(6); PG8_BAR; PG8_MMA(1, 1, At, B1); PG8_BAR;
            }
        }
        if constexpr (ALIGN_EPI) { if (wr == 0) PG8_BAR; }
        if constexpr (FP8) asm volatile("s_nop 15\n\ts_nop 15" ::: "memory");
        if constexpr (!Epi::AFTER_DRAIN) { E(acc, cur, wr, wc, fr, fq); S.done(cur); }
        if (!has_next) break;
#pragma unroll
        for (int a = 0; a < 2; ++a)
#pragma unroll
            for (int b = 0; b < 2; ++b)
#pragma unroll
                for (int m = 0; m < 4; ++m)
#pragma unroll
                    for (int n = 0; n < 2; ++n) acc[a][b][m][n] = (f32x4){0.f, 0.f, 0.f, 0.f};
        cur = nxt; cA = nA; cB = nB; ++ui;
        if constexpr (ALIGN_EPI) { if (wr == 1) PG8_BAR; }
    }
    PG8_WAIT_V(0);
    if constexpr (!ALIGN_EPI) { if (wr == 0) PG8_BAR; }
    PG8_BAR;
    if constexpr (Epi::AFTER_DRAIN) { E.fused(acc, cur, wr, wc, fr, fq, lds, wid, lane); S.done(cur); }
#undef PG8_SA
#undef PG8_SB
#undef PG8_STAGE
#undef PG8_LDA
#undef PG8_LD16
#undef PG8_CAT8
#undef PG8_LDB
#undef PG8_MMA
#undef PG8_WAIT_V
#undef PG8_WAIT_L
#undef PG8_BAR
#undef PG8_SCHED
}
}
constexpr int NWAVES = 8;
#ifndef MK_N_LAUNCHES
#define MK_N_LAUNCHES 1
#endif
#ifndef USE_FUSED_CONV
#define USE_FUSED_CONV 1
#endif
#ifndef USE_MFMA_ATTN
#define USE_MFMA_ATTN 1
#endif
#ifndef USE_FP8_B
#define USE_FP8_B 1
#endif
#ifndef REP_P0
#define REP_P0 1
#endif
#ifndef REP_P7
#define REP_P7 1
#endif
constexpr int NPH = 10;
constexpr int N_LAUNCHES = MK_N_LAUNCHES;
static_assert(N_LAUNCHES == 1 || N_LAUNCHES == NPH, "MK_N_LAUNCHES is 1 or NPH");

constexpr int D = 4096, M = 16384, NH = 64, HD = 64, NKV = 8, KVD = NKV * HD, WIN = 128;
constexpr int NMOD = 32768;
constexpr int MOD_A = 0, MOD_KV = 12288, MOD_B = 20480;
constexpr float EPS = 1e-6f;
constexpr float LOG2E = 1.4426950408889634f;
constexpr float QSCALE = 0.125f * LOG2E;

constexpr size_t MiB = 1u << 20;
constexpr size_t WS_CTL = 0, CTL_ZERO_BYTES = 1 * MiB;
constexpr size_t WS_MODP = 1 * MiB;
constexpr size_t WS_MODV = 1 * MiB + 512 * 1024;
constexpr size_t WS_WAIN = 2 * MiB, WS_WAOUT = 130 * MiB, WS_WKV = 162 * MiB, WS_WBIN = 170 * MiB, WS_WBOUT = 234 * MiB;
constexpr size_t WS_HA = 266 * MiB;
constexpr size_t WS_Y = 394 * MiB;
constexpr size_t WS_X1 = 522 * MiB;
constexpr size_t WS_BIG = 778 * MiB;
constexpr size_t WS_Q = WS_BIG, WS_Z = WS_BIG + 128 * MiB, WS_AG = WS_BIG + 256 * MiB, WS_K = WS_BIG + 384 * MiB, WS_V = WS_BIG + 400 * MiB;
constexpr size_t WS_HALO = WS_BIG + 416 * MiB;
constexpr size_t WS_END = 1290 * MiB;
constexpr int CW_TMO = 0, CW_CODE = 1;
constexpr int CW_BAR = 4096;

constexpr int RING_OFF = 0, RING_BYTES = 131072;
constexpr int LDSCTL_OFF = RING_BYTES, MISC_OFF = LDSCTL_OFF + 320;
constexpr int XCH_OFF = LDSCTL_OFF + 1024;
constexpr int LDS_BYTES = 147456;
static_assert(XCH_OFF + 8192 <= LDS_BYTES, "LDS map");

#define GAS __attribute__((address_space(1)))
#define LAS __attribute__((address_space(3)))
typedef unsigned short bf16;
typedef unsigned v4u __attribute__((ext_vector_type(4)));
typedef unsigned v2u __attribute__((ext_vector_type(2)));
typedef float f32x4 __attribute__((ext_vector_type(4)));
typedef GAS unsigned gu32;
#define RLX_AGENT __ATOMIC_RELAXED, __HIP_MEMORY_SCOPE_AGENT
#define LDS_WAIT() asm volatile("s_waitcnt lgkmcnt(0)" ::: "memory")
#define VM_WAIT() asm volatile("s_waitcnt vmcnt(0)" ::: "memory")
__device__ __forceinline__ unsigned f2bf(float f) { unsigned u = __builtin_bit_cast(unsigned, f); return (u + 0x7fffu + ((u >> 16) & 1u)) >> 16; }
__device__ __forceinline__ unsigned pk2(float lo, float hi) { return f2bf(lo) | (f2bf(hi) << 16); }
__device__ __forceinline__ float bflo(unsigned w) { return __builtin_bit_cast(float, w << 16); }
__device__ __forceinline__ float bfhi(unsigned w) { return __builtin_bit_cast(float, w & 0xffff0000u); }
__device__ __forceinline__ unsigned pk4_fp8(float a, float b, float c, float d) { int w = 0; w = __builtin_amdgcn_cvt_pk_fp8_f32(a, b, w, false); w = __builtin_amdgcn_cvt_pk_fp8_f32(c, d, w, true); return (unsigned)w; }
constexpr float W8_SCALE = 256.0f, W8_INV = 1.0f / 256.0f;
__device__ __forceinline__ float silu(float v) { return v * __builtin_amdgcn_rcpf(1.0f + __expf(-v)); }

#define XB_TMO      128
#define XB_XCNT(j)  (256  + 64 * (j))
#define XB_XSUB(j)  (1280 + 64 * (j))
#define XB_XGEN(j)  (2304 + 64 * (j))
#define XB_TOP      3328
#define XB_TOPGEN   3392
#define XCD_BAR_WORDS 3456
#define XB_SPIN_CAP (1u << 18)

__device__ __forceinline__ unsigned xb_ld(unsigned* p)              { return __hip_atomic_load(p, __ATOMIC_RELAXED, __HIP_MEMORY_SCOPE_AGENT); }
__device__ __forceinline__ unsigned xb_add(unsigned* p, unsigned v) { return __hip_atomic_fetch_add(p, v, __ATOMIC_RELAXED, __HIP_MEMORY_SCOPE_AGENT); }
__device__ __forceinline__ unsigned xb_xcc_id() { return (unsigned)__builtin_amdgcn_s_getreg((3 << 11) | 20) & 0xFu; }
#define XB_SPIN(cond, bar) do { unsigned _sp = 0; while (cond) { __builtin_amdgcn_s_sleep(1); \
    if ((++_sp & 255u) == 0u) { if (xb_ld(&(bar)[XB_TMO])) break; if (_sp > XB_SPIN_CAP) { atomicAdd(&(bar)[XB_TMO], 1u); break; } } } } while (0)

struct XcdBarrier {
    unsigned* bar; unsigned x;
    volatile LAS unsigned* st;
};

__device__ __forceinline__ XcdBarrier xcd_barrier_post(unsigned* bar, volatile LAS unsigned* st) {
    XcdBarrier b; b.bar = bar; b.x = xb_xcc_id(); b.st = st;
    if (threadIdx.x == 0) (void)xb_add(&bar[XB_XCNT(b.x)], 1u);
    return b;
}
__device__ __forceinline__ void xcd_barrier_complete(unsigned* bar, unsigned x, unsigned& nloc, unsigned& nx) {
    const unsigned G = gridDim.x * gridDim.y * gridDim.z;
    unsigned sum, cnt, mine, sp = 0u;
    for (;;) {
        sum = 0u; cnt = 0u; mine = 0u;
#pragma unroll
        for (unsigned j = 0; j < 16; ++j) { const unsigned c = xb_ld(&bar[XB_XCNT(j)]); sum += c; cnt += (c > 0u) ? 1u : 0u; mine = (j == x) ? c : mine; }
        if (sum == G) break;
        __builtin_amdgcn_s_sleep(1);
        if ((++sp & 255u) == 0u) { if (xb_ld(&bar[XB_TMO])) break; if (sp > XB_SPIN_CAP) { atomicAdd(&bar[XB_TMO], 1u); break; } }
    }
    nloc = mine > 0u ? mine : 1u; nx = cnt > 0u ? cnt : 1u;
}

__device__ __forceinline__ void xcd_barrier(const XcdBarrier& b) {
    asm volatile("s_waitcnt vmcnt(0)" ::: "memory");
    __syncthreads();
    if (threadIdx.x == 0) {
        unsigned* bar = b.bar;
        __builtin_amdgcn_s_waitcnt(0);
        unsigned nloc = b.st[0], nx = b.st[1];
        if (nloc == 0u) { xcd_barrier_complete(bar, b.x, nloc, nx); b.st[0] = nloc; b.st[1] = nx; }
        const unsigned old = xb_add(&bar[XB_XSUB(b.x)], 1u);
        const unsigned gen = old / nloc;
        if (old + 1u == (gen + 1u) * nloc) {
            __builtin_amdgcn_fence(__ATOMIC_RELEASE, "agent");
            asm volatile("s_waitcnt vmcnt(0)" ::: "memory");
            const unsigned og = xb_add(&bar[XB_TOP], 1u);
            const unsigned tg = og / nx;
            if (og + 1u == (tg + 1u) * nx) xb_add(&bar[XB_TOPGEN], 1u);
            else XB_SPIN(xb_ld(&bar[XB_TOPGEN]) == tg, bar);
            __builtin_amdgcn_fence(__ATOMIC_ACQUIRE, "agent");
            xb_add(&bar[XB_XGEN(b.x)], 1u);
            asm volatile("s_waitcnt vmcnt(0)" ::: "memory");
        } else {
            XB_SPIN(xb_ld(&bar[XB_XGEN(b.x)]) == gen, bar);
            __builtin_amdgcn_fence(__ATOMIC_ACQUIRE, "agent");
            asm volatile("s_waitcnt vmcnt(0)" ::: "memory");
        }
    }
    __syncthreads();
}

__device__ __forceinline__ float wave_sum(float v) {
#pragma unroll
    for (int o = 1; o < 64; o <<= 1) v += __shfl_xor(v, o);
    return v;
}
__device__ __forceinline__ float bcat(const float* ba, const float* bkv, const float* bb, int n) { return n < MOD_KV ? ba[n] : (n < MOD_B ? bkv[n - MOD_KV] : bb[n - MOD_B]); }

__device__ __forceinline__ void p0_gemv(LAS unsigned char* lds, const float* c, const float* wa, const float* wkv, const float* wb, float* modp, int vcu, int G, int tid, int lane, int wave) {
    LAS float* SC = (LAS float*)lds;
    LAS float* RED = (LAS float*)(lds + 16384);
    for (int i = tid; i < D; i += NWAVES * 64) SC[i] = silu(c[i]);
    __syncthreads();
    for (int uu = vcu; uu < 256 * REP_P0; uu += G) {
        const int u = uu & 255, ch = u >> 1, kh = u & 1;
        const float* W; int pitch, col;
        if (ch < 48) { W = wa; pitch = 12288; col = ch * 256; } else if (ch < 80) { W = wkv; pitch = 8192; col = (ch - 48) * 256; } else { W = wb; pitch = 12288; col = (ch - 80) * 256; }
        const int k0 = kh * 2048 + wave * 256;
        const float* p = W + (size_t)k0 * pitch + col + 4 * lane;
        f32x4 a0 = {0.f, 0.f, 0.f, 0.f}, a1 = a0;
#pragma unroll 4
        for (int k = 0; k < 256; k += 2) {
            const f32x4 w0 = *(const f32x4*)(p + (size_t)k * pitch), w1 = *(const f32x4*)(p + (size_t)(k + 1) * pitch);
            a0 += w0 * SC[k0 + k]; a1 += w1 * SC[k0 + k + 1];
        }
        a0 += a1;
        *(LAS f32x4*)(RED + wave * 256 + 4 * lane) = a0;
        __syncthreads();
        if (tid < 256) { float s = 0.f;
#pragma unroll
            for (int w = 0; w < 8; ++w) s += RED[w * 256 + tid];
            modp[kh * NMOD + ch * 256 + tid] = s; }
        __syncthreads();
    }
}

template <int PERMUTE>
__device__ __forceinline__ void p0_transpose_item(const float* W, int N, bf16* WT, LAS unsigned short* T, int item, int lane) {
    const int nblk = N / 64, kb = item / nblk, nb = item % nblk, k0 = 64 * kb, n0 = 64 * nb;
    f32x4 v[16];
    const int kk0 = lane >> 4, nn = 4 * (lane & 15);
#pragma unroll
    for (int i = 0; i < 16; ++i) v[i] = *(const f32x4*)(W + (size_t)(k0 + 4 * i + kk0) * N + n0 + nn);
#pragma unroll
    for (int i = 0; i < 16; ++i) { const int kk = 4 * i + kk0;
        T[(nn + 0) * 72 + kk] = (unsigned short)f2bf(v[i][0]); T[(nn + 1) * 72 + kk] = (unsigned short)f2bf(v[i][1]);
        T[(nn + 2) * 72 + kk] = (unsigned short)f2bf(v[i][2]); T[(nn + 3) * 72 + kk] = (unsigned short)f2bf(v[i][3]); }
    LDS_WAIT(); asm volatile("" ::: "memory");
    const int c = lane & 7;
#pragma unroll
    for (int j = 0; j < 8; ++j) { const int n = (lane >> 3) + 8 * j;
        const v4u o = *(const LAS v4u*)(T + n * 72 + 8 * c);
        int nsrc = n0 + n, ndst = nsrc;
        if (PERMUTE) {
            const int q = nsrc >> 12, chn = nsrc & 4095;
            ndst = 256 * (chn >> 6) + 128 * (q >> 1) + 32 * ((chn >> 4) & 3) + 8 * ((chn >> 2) & 3) + 4 * (q & 1) + (chn & 3);
        }
        *(v4u*)(WT + (size_t)ndst * D + k0 + 8 * c) = o; }
    LDS_WAIT(); asm volatile("" ::: "memory");
}

__device__ __forceinline__ void p0_transpose_item_fp8(const float* W, int N, unsigned char* WT, LAS unsigned char* T, int item, int lane) {
    const int nblk = N / 32, kb = item / nblk, nb = item % nblk, k0 = 128 * kb, n0 = 32 * nb;
    f32x4 v[16];
    const int kk0 = lane >> 3, nn = 4 * (lane & 7);
#pragma unroll
    for (int i = 0; i < 16; ++i) v[i] = *(const f32x4*)(W + (size_t)(k0 + 8 * i + kk0) * N + n0 + nn);
#pragma unroll
    for (int i = 0; i < 16; ++i) { const int kk = 8 * i + kk0; const unsigned w = pk4_fp8(v[i][0] * W8_SCALE, v[i][1] * W8_SCALE, v[i][2] * W8_SCALE, v[i][3] * W8_SCALE);
        T[(nn + 0) * 144 + kk] = (unsigned char)(w & 0xffu); T[(nn + 1) * 144 + kk] = (unsigned char)((w >> 8) & 0xffu);
        T[(nn + 2) * 144 + kk] = (unsigned char)((w >> 16) & 0xffu); T[(nn + 3) * 144 + kk] = (unsigned char)(w >> 24); }
    LDS_WAIT(); asm volatile("" ::: "memory");
    const int c = lane & 7;
#pragma unroll
    for (int j = 0; j < 4; ++j) { const int n = (lane >> 3) + 8 * j;
        const v4u o = *(const LAS v4u*)(T + n * 144 + 16 * c);
        *(v4u*)(WT + (size_t)(n0 + n) * D + k0 + 16 * c) = o; }
    LDS_WAIT(); asm volatile("" ::: "memory");
}

template <int NOUT>
__device__ __forceinline__ void norm_rows_fp8(const float* X, unsigned char* O0, unsigned char* O1, const LAS float* GS, int gw, int NGW, int lane) {
    for (int m = gw; m < M; m += NGW) {
        asm volatile("" ::: "memory");
        const f32x4* xr = (const f32x4*)(X + (size_t)m * D) + 2 * lane;
        f32x4 v[8][2]; float s = 0.f;
#pragma unroll
        for (int j = 0; j < 8; ++j)
#pragma unroll
            for (int hh = 0; hh < 2; ++hh) { v[j][hh] = xr[128 * j + hh]; const f32x4 t = v[j][hh]; s += (t[0] * t[0] + t[1] * t[1]) + (t[2] * t[2] + t[3] * t[3]); }
        const float rstd = __builtin_amdgcn_rsqf(wave_sum(s) * (1.f / D) + EPS);
#pragma unroll
        for (int o = 0; o < NOUT; ++o) {
            v2u* op = (v2u*)((o == 0 ? O0 : O1) + (size_t)m * D) + lane;
#pragma unroll
            for (int j = 0; j < 8; ++j) {
                const int col = 512 * j + 8 * lane;
                const f32x4 ga = *(const LAS f32x4*)(GS + (o * 2 + 0) * D + col), gb = *(const LAS f32x4*)(GS + (o * 2 + 0) * D + col + 4);
                const f32x4 sa = *(const LAS f32x4*)(GS + (o * 2 + 1) * D + col), sb = *(const LAS f32x4*)(GS + (o * 2 + 1) * D + col + 4);
                const f32x4 ya = v[j][0] * rstd * ga + sa, yb = v[j][1] * rstd * gb + sb;
                v2u w; w.x = pk4_fp8(ya[0], ya[1], ya[2], ya[3]); w.y = pk4_fp8(yb[0], yb[1], yb[2], yb[3]); op[64 * j] = w; }
        }
    }
}

template <int NOUT>
__device__ __forceinline__ void norm_rows_bf16(const float* X, bf16* O0, bf16* O1, const LAS float* GS, int gw, int NGW, int lane) {
    for (int m = gw; m < M; m += NGW) {
        asm volatile("" ::: "memory");
        const f32x4* xr = (const f32x4*)(X + (size_t)m * D) + lane;
        f32x4 v[16]; float s = 0.f;
#pragma unroll
        for (int j = 0; j < 16; ++j) { v[j] = xr[64 * j]; s += (v[j][0] * v[j][0] + v[j][1] * v[j][1]) + (v[j][2] * v[j][2] + v[j][3] * v[j][3]); }
        const float rstd = __builtin_amdgcn_rsqf(wave_sum(s) * (1.f / D) + EPS);
#pragma unroll
        for (int o = 0; o < NOUT; ++o) {
            v2u* op = (v2u*)((o == 0 ? O0 : O1) + (size_t)m * D) + lane;
#pragma unroll
            for (int j = 0; j < 16; ++j) {
                const f32x4 g4 = *(const LAS f32x4*)(GS + (o * 2 + 0) * D + 256 * j + 4 * lane), s4 = *(const LAS f32x4*)(GS + (o * 2 + 1) * D + 256 * j + 4 * lane);
                const f32x4 y = v[j] * rstd * g4 + s4;
                v2u w; w.x = pk2(y[0], y[1]); w.y = pk2(y[2], y[3]); op[64 * j] = w; }
        }
    }
}

__device__ __forceinline__ void convgate_naive(const bf16* P, const float* cw, bf16* Y, int gtid, int total) {
    for (size_t idx = (size_t)gtid; idx < (size_t)M * 512; idx += (size_t)total) {
        const int t = (int)(idx >> 9), j = (int)(idx & 511) * 8;
        const bf16* r0 = P + (size_t)t * 16384 + j;
        const v4u zero = {0u, 0u, 0u, 0u};
        const v4u bq = *(const v4u*)(r0), zq = *(const v4u*)(r0 + 12288);
        const v4u c0 = *(const v4u*)(r0 + 4096), u0 = *(const v4u*)(r0 + 8192);
        const v4u c1 = t >= 1 ? *(const v4u*)(r0 - 16384 + 4096) : zero, u1 = t >= 1 ? *(const v4u*)(r0 - 16384 + 8192) : zero;
        const v4u c2 = t >= 2 ? *(const v4u*)(r0 - 32768 + 4096) : zero, u2 = t >= 2 ? *(const v4u*)(r0 - 32768 + 8192) : zero;
        float w0[8], w1[8], w2[8];
#pragma unroll
        for (int e = 0; e < 8; e += 4) { const f32x4 a = *(const f32x4*)(cw + j + e), b = *(const f32x4*)(cw + D + j + e), c = *(const f32x4*)(cw + 2 * D + j + e);
#pragma unroll
            for (int i = 0; i < 4; ++i) { w0[e + i] = a[i]; w1[e + i] = b[i]; w2[e + i] = c[i]; } }
        v4u o;
#pragma unroll
        for (int e = 0; e < 4; ++e) {
            float y[2];
#pragma unroll
            for (int hh = 0; hh < 2; ++hh) {
                const float b = hh ? bfhi(bq[e]) : bflo(bq[e]), z = hh ? bfhi(zq[e]) : bflo(zq[e]);
                const float cu0 = (hh ? bfhi(c0[e]) : bflo(c0[e])) * (hh ? bfhi(u0[e]) : bflo(u0[e]));
                const float cu1 = (hh ? bfhi(c1[e]) : bflo(c1[e])) * (hh ? bfhi(u1[e]) : bflo(u1[e]));
                const float cu2 = (hh ? bfhi(c2[e]) : bflo(c2[e])) * (hh ? bfhi(u2[e]) : bflo(u2[e]));
                const int ee = 2 * e + hh;
                y[hh] = b * (w0[ee] * cu2 + w1[ee] * cu1 + w2[ee] * cu0) * silu(z);
            }
            o[e] = pk2(y[0], y[1]);
        }
        *(v4u*)(Y + (size_t)t * D + j) = o;
    }
}

__device__ __forceinline__ int t5_bucket(int d) { if (d < 16) return d; const int b = 16 + (int)(__log2f((float)d * 0.0625f) * (16.0f / 3.0f)); return b < 31 ? b : 31; }

__device__ __forceinline__ void attn_naive(LAS unsigned char* lds, const bf16* Q, const bf16* K, const bf16* V, const bf16* Z, bf16* O, const float* rel_bias, const float* sinks, int gtid, int total, int tid) {
    LAS float* BT = (LAS float*)lds;
    for (int i = tid; i < NH * WIN; i += NWAVES * 64) { const int h = i >> 7, d = i & 127; BT[i] = rel_bias[t5_bucket(d) * NH + h] * LOG2E; }
    __syncthreads();
    for (int idx = gtid; idx < M * NH; idx += total) {
        const int h = idx >> 14, t = idx & (M - 1), g = h >> 3;
        float q[64], acc[64];
        { const v4u* qp = (const v4u*)(Q + (size_t)t * D + h * 64);
#pragma unroll
          for (int c = 0; c < 8; ++c) { const v4u w = qp[c];
#pragma unroll
              for (int e = 0; e < 4; ++e) { q[8 * c + 2 * e] = bflo(w[e]); q[8 * c + 2 * e + 1] = bfhi(w[e]); } } }
#pragma unroll
        for (int d = 0; d < 64; ++d) acc[d] = 0.f;
        float mx = sinks[h] * LOG2E, l = 1.f;
        const int nd = t < WIN - 1 ? t : WIN - 1;
        for (int i = 0; i <= nd; ++i) {
            const int s = t - i;
            const v4u* kp = (const v4u*)(K + (size_t)s * KVD + g * 64);
            float dot = 0.f;
#pragma unroll
            for (int c = 0; c < 8; ++c) { const v4u w = kp[c];
#pragma unroll
                for (int e = 0; e < 4; ++e) { dot += q[8 * c + 2 * e] * bflo(w[e]); dot += q[8 * c + 2 * e + 1] * bfhi(w[e]); } }
            const float lg = dot + BT[h * WIN + i];
            const float mn = fmaxf(mx, lg), f = __builtin_amdgcn_exp2f(mx - mn), p = __builtin_amdgcn_exp2f(lg - mn);
            l = l * f + p; mx = mn;
            const v4u* vp = (const v4u*)(V + (size_t)s * KVD + g * 64);
#pragma unroll
            for (int c = 0; c < 8; ++c) { const v4u w = vp[c];
#pragma unroll
                for (int e = 0; e < 4; ++e) { acc[8 * c + 2 * e] = acc[8 * c + 2 * e] * f + p * bflo(w[e]); acc[8 * c + 2 * e + 1] = acc[8 * c + 2 * e + 1] * f + p * bfhi(w[e]); } }
        }
        const float inv = 1.0f / l;
        const v4u* zp = (const v4u*)(Z + (size_t)t * D + h * 64); v4u* op = (v4u*)(O + (size_t)t * D + h * 64);
#pragma unroll
        for (int c = 0; c < 8; ++c) { const v4u w = zp[c]; v4u o;
#pragma unroll
            for (int e = 0; e < 4; ++e) o[e] = pk2(acc[8 * c + 2 * e] * inv * bflo(w[e]), acc[8 * c + 2 * e + 1] * inv * bfhi(w[e]));
            op[c] = o; }
    }
}


__device__ __forceinline__ void conv_fixup(const float* BSH, const float* PCH, const float* CUH, const float* cw, bf16* Y, int gtid, int total) {
    for (int idx = gtid; idx < 63 * 2 * 1024; idx += total) {
        const int c4 = (idx & 1023) * 4, r = (idx >> 10) & 1, pm = (idx >> 11) + 1;
        const f32x4 bs = *(const f32x4*)(BSH + ((size_t)pm * 2 + r) * D + c4), pc = *(const f32x4*)(PCH + ((size_t)pm * 2 + r) * D + c4);
        const f32x4 w0 = *(const f32x4*)(cw + c4), w1 = *(const f32x4*)(cw + D + c4);
        const f32x4 cA = *(const f32x4*)(CUH + ((size_t)(pm - 1) * 2 + 0) * D + c4), cB = *(const f32x4*)(CUH + ((size_t)(pm - 1) * 2 + 1) * D + c4);
        const f32x4 extra = r == 0 ? w0 * cA + w1 * cB : w0 * cB;
        const f32x4 y = bs * (pc + extra);
        v2u w; w.x = pk2(y[0], y[1]); w.y = pk2(y[2], y[3]);
        *(v2u*)(Y + ((size_t)pm * 256 + r) * D + c4) = w;
    }
}

namespace swa {
typedef short bf16x8 __attribute__((ext_vector_type(8)));
typedef float f32x16 __attribute__((ext_vector_type(16)));
constexpr int KP = 144, VP = 520;
constexpr int LDS_K = 0, LDS_V = 256 * KP, LDS_BT = LDS_V + 64 * VP, LDS_END = LDS_BT + NH * WIN * 4;
static_assert(LDS_V % 16 == 0 && LDS_BT % 16 == 0 && LDS_END <= RING_BYTES, "attention LDS map");
__device__ __forceinline__ int crow(int r, int hi) { return (r & 3) + 8 * (r >> 2) + 4 * hi; }
__device__ __forceinline__ void attn_phase(LAS unsigned char* lds, const bf16* Q, const bf16* K, const bf16* V, const bf16* Z, bf16* O, const float* rel_bias, const float* sinks, int vcu, int G, int tid, int lane, int wave) {
    LAS float* BT = (LAS float*)(lds + LDS_BT);
    for (int i = tid; i < NH * WIN; i += NWAVES * 64) { const int h = i >> 7, d = i & 127; BT[i] = rel_bias[t5_bucket(d) * NH + h] * LOG2E; }
    const int al = lane & 31, hi = lane >> 5;
    LAS unsigned short* vt = (LAS unsigned short*)(lds + LDS_V);
    for (int uu = vcu; uu < (M / 128) * NKV * REP_P7; uu += G) {
        const int u = uu % ((M / 128) * NKV), qb = u >> 3, g = u & 7, h = 8 * g + wave;
        __syncthreads();
#pragma unroll
        for (int j = 0; j < 4; ++j) {
            const int idx = tid + NWAVES * 64 * j, key = idx >> 3, ch = idx & 7, pos = 128 * (qb - 1) + key;
            v4u kv = {0u, 0u, 0u, 0u}, vv = kv;
            if (pos >= 0) { kv = *(const v4u*)(K + (size_t)pos * KVD + g * 64 + ch * 8); vv = *(const v4u*)(V + (size_t)pos * KVD + g * 64 + ch * 8); }
            *(LAS v4u*)(lds + LDS_K + key * KP + ch * 16) = kv;
#pragma unroll
            for (int e = 0; e < 4; ++e) { vt[(ch * 8 + 2 * e) * (VP / 2) + key] = (unsigned short)(vv[e] & 0xffffu); vt[(ch * 8 + 2 * e + 1) * (VP / 2) + key] = (unsigned short)(vv[e] >> 16); }
        }
        __syncthreads();
        const float sink2 = sinks[h] * LOG2E;
        const LAS float* bt = BT + h * WIN;
        for (int i = 0; i < 4; ++i) {
            const int t0 = 128 * qb + 32 * i;
            bf16x8 qr[4];
            { const bf16* qp = Q + (size_t)(t0 + al) * D + h * 64 + 8 * hi;
#pragma unroll
              for (int s = 0; s < 4; ++s) qr[s] = *(const bf16x8*)(qp + 16 * s); }
            f32x16 S[5];
#pragma unroll
            for (int jj = 0; jj < 5; ++jj) {
                const LAS unsigned char* kp = lds + LDS_K + (32 * (i + jj) + al) * KP + hi * 16;
                f32x16 a = {0.f, 0.f, 0.f, 0.f, 0.f, 0.f, 0.f, 0.f, 0.f, 0.f, 0.f, 0.f, 0.f, 0.f, 0.f, 0.f};
#pragma unroll
                for (int s = 0; s < 4; ++s) { const bf16x8 kf = *(const LAS bf16x8*)(kp + s * 32); a = __builtin_amdgcn_mfma_f32_32x32x16_bf16(kf, qr[s], a, 0, 0, 0); }
                S[jj] = a;
            }
            float mx = sink2;
#pragma unroll
            for (int jj = 0; jj < 5; ++jj) {
#pragma unroll
                for (int r = 0; r < 16; ++r) {
                    const int kr = crow(r, hi), dist = 128 - 32 * jj + al - kr, b = 32 * (i + jj) + kr;
                    const bool inband = (jj >= 1 && jj <= 3) ? true : (dist >= 0 && dist < WIN);
                    const bool valid = inband && (qb > 0 || b >= 128);
                    const float v = valid ? S[jj][r] + bt[dist & (WIN - 1)] : -INFINITY;
                    S[jj][r] = v; mx = fmaxf(mx, v);
                }
                asm volatile("" ::: "memory");
            }
            mx = fmaxf(mx, __shfl_xor(mx, 32));
            float l = 0.f;
            v4u P[5][2];
#pragma unroll
            for (int jj = 0; jj < 5; ++jj)
#pragma unroll
                for (int ks = 0; ks < 2; ++ks)
#pragma unroll
                    for (int e = 0; e < 4; ++e) {
                        const float p0 = __builtin_amdgcn_exp2f(S[jj][8 * ks + 2 * e] - mx), p1 = __builtin_amdgcn_exp2f(S[jj][8 * ks + 2 * e + 1] - mx);
                        l += p0 + p1; P[jj][ks][e] = pg8::cvt_pk_bf16(p0, p1);
                    }
            l += __shfl_xor(l, 32);
            l += __builtin_amdgcn_exp2f(sink2 - mx);
            const float inv = 1.0f / l;
            f32x16 o[2];
            o[0] = (f32x16){0.f, 0.f, 0.f, 0.f, 0.f, 0.f, 0.f, 0.f, 0.f, 0.f, 0.f, 0.f, 0.f, 0.f, 0.f, 0.f}; o[1] = o[0];
#pragma unroll
            for (int jj = 0; jj < 5; ++jj)
#pragma unroll
                for (int ks = 0; ks < 2; ++ks) {
                    const bf16x8 pf = __builtin_bit_cast(bf16x8, P[jj][ks]);
                    const int kb = 32 * (i + jj) + 16 * ks + 4 * hi;
#pragma unroll
                    for (int db = 0; db < 2; ++db) {
                        const LAS unsigned char* vp = lds + LDS_V + (32 * db + al) * VP + kb * 2;
                        const v2u lo = *(const LAS v2u*)vp, hh = *(const LAS v2u*)(vp + 16);
                        const v4u vw = {lo.x, lo.y, hh.x, hh.y};
                        o[db] = __builtin_amdgcn_mfma_f32_32x32x16_bf16(__builtin_bit_cast(bf16x8, vw), pf, o[db], 0, 0, 0);
                    }
                }
#pragma unroll
            for (int db = 0; db < 2; ++db)
#pragma unroll
                for (int rq = 0; rq < 4; ++rq) {
                    const size_t off = (size_t)(t0 + al) * D + h * 64 + 32 * db + 8 * rq + 4 * hi;
                    const v2u zz = *(const v2u*)(Z + off);
                    v2u w; w.x = pk2(o[db][4 * rq] * inv * bflo(zz.x), o[db][4 * rq + 1] * inv * bfhi(zz.x)); w.y = pk2(o[db][4 * rq + 2] * inv * bflo(zz.y), o[db][4 * rq + 3] * inv * bfhi(zz.y));
                    *(v2u*)(O + off) = w;
                }
        }
    }
}
}

__device__ __forceinline__ void final_norm(float* X, const LAS float* G, int gw, int NGW, int lane) {
    for (int m = gw; m < M; m += NGW) {
        asm volatile("" ::: "memory");
        f32x4* xr = (f32x4*)(X + (size_t)m * D) + lane;
        f32x4 v[16]; float s = 0.f;
#pragma unroll
        for (int j = 0; j < 16; ++j) { v[j] = xr[64 * j]; s += (v[j][0] * v[j][0] + v[j][1] * v[j][1]) + (v[j][2] * v[j][2] + v[j][3] * v[j][3]); }
        const float rstd = __builtin_amdgcn_rsqf(wave_sum(s) * (1.f / D) + EPS);
#pragma unroll
        for (int j = 0; j < 16; ++j) xr[64 * j] = v[j] * rstd * *(const LAS f32x4*)(G + 256 * j + 4 * lane);
    }
}

struct Args { const float* in[20]; float* out; unsigned char* ws; int ph_lo, ph_hi; };
static_assert(sizeof(Args) == 22 * 8 + 8, "Args has no padding");
__global__ void __launch_bounds__(NWAVES * 64, 2) mk_fwd(Args args) {
    extern __shared__ __attribute__((aligned(16))) unsigned char lds_raw[];
    LAS unsigned char* lds = (LAS unsigned char*)lds_raw;
    volatile LAS unsigned* MISC = (volatile LAS unsigned*)(lds + MISC_OFF);
    const int tid = threadIdx.x, lane = tid & 63, wave = __builtin_amdgcn_readfirstlane(tid >> 6);
    const int G = gridDim.x; const int bx = blockIdx.x; const int vcu = (G % 8 == 0) ? (bx % 8) * (G / 8) + bx / 8 : bx;
    const int gw = vcu * NWAVES + wave, NGW = G * NWAVES, gtid = bx * (NWAVES * 64) + tid, gtotal = G * NWAVES * 64;
    unsigned char* ws = args.ws;
    gu32* ctl = (gu32*)(ws + WS_CTL);
    const float* x = args.in[0]; const float* cvec = args.in[1]; const float* g_a = args.in[2]; const float* w_mod_a = args.in[3]; const float* b_mod_a = args.in[4];
    const float* w_a_in = args.in[5]; const float* conv_a = args.in[6]; const float* w_a_out = args.in[7]; const float* g_kv = args.in[8]; const float* w_mod_kv = args.in[9];
    const float* b_mod_kv = args.in[10]; const float* w_kv = args.in[11]; const float* rel_bias = args.in[12]; const float* g_b = args.in[13]; const float* w_mod_b = args.in[14];
    const float* b_mod_b = args.in[15]; const float* w_b_in = args.in[16]; const float* sinks_b = args.in[17]; const float* w_b_out = args.in[18]; const float* g_final = args.in[19];
    float* out = args.out;
    float* modp = (float*)(ws + WS_MODP); float* modv = (float*)(ws + WS_MODV);
    bf16* W_AIN = (bf16*)(ws + WS_WAIN); bf16* W_AOUT = (bf16*)(ws + WS_WAOUT); bf16* W_KV = (bf16*)(ws + WS_WKV); bf16* W_BIN = (bf16*)(ws + WS_WBIN); bf16* W_BOUT = (bf16*)(ws + WS_WBOUT);
    bf16* HA = (bf16*)(ws + WS_HA); bf16* YB = (bf16*)(ws + WS_Y); float* X1 = (float*)(ws + WS_X1); bf16* PROJ = (bf16*)(ws + WS_BIG);
    float* CUH = (float*)(ws + WS_HALO); float* BSH = (float*)(ws + WS_HALO + 2 * MiB); float* PCH = (float*)(ws + WS_HALO + 4 * MiB);
    bf16* QB = (bf16*)(ws + WS_Q); bf16* ZB = (bf16*)(ws + WS_Z); bf16* AG = (bf16*)(ws + WS_AG); bf16* KB = (bf16*)(ws + WS_K); bf16* VB = (bf16*)(ws + WS_V);

    for (int u = tid; u < (LDS_BYTES - LDSCTL_OFF) / 4; u += NWAVES * 64) ((LAS unsigned*)(lds + LDSCTL_OFF))[u] = 0u;
    __syncthreads();
    XcdBarrier bar; bar.bar = (unsigned*)(ctl + CW_BAR); bar.x = 0; bar.st = nullptr;
    if (N_LAUNCHES == 1) bar = xcd_barrier_post((unsigned*)(ctl + CW_BAR), MISC + 8);
#define GRID_BAR(seam) do { if (N_LAUNCHES != 1) { if (tid == 0) __hip_atomic_store(ctl + CW_TMO, 0xBADBA0u | (unsigned)(seam), RLX_AGENT); } else { xcd_barrier(bar); } } while (0)
    const int lo = args.ph_lo, hi = args.ph_hi;
#define IN(k) (lo <= (k) && (k) < hi)
#define BOTH(k) (IN(k) && IN((k) + 1))

    if (IN(0)) {
        p0_gemv(lds, cvec, w_mod_a, w_mod_kv, w_mod_b, modp, vcu, G, tid, lane, wave);
        LAS unsigned short* T = (LAS unsigned short*)(lds + wave * 9216);
        constexpr int I_AIN = 64 * 256, I_AOUT = 64 * 64, I_KV = 64 * 16, I_BIN = 64 * 128, I_BOUT = 64 * 64, NITEMS = I_AIN + I_AOUT + I_KV + I_BIN + I_BOUT;
        for (int it = gw; it < NITEMS * REP_P0; it += NGW) {
            int r = it % NITEMS;
            if (r < I_AIN) { p0_transpose_item<USE_FUSED_CONV>(w_a_in, 16384, W_AIN, T, r, lane); continue; } r -= I_AIN;
            if (r < I_AOUT) { p0_transpose_item<0>(w_a_out, 4096, W_AOUT, T, r, lane); continue; } r -= I_AOUT;
#if USE_FP8_B >= 1
            if (r < I_KV) { p0_transpose_item_fp8(w_kv, 1024, (unsigned char*)W_KV, (LAS unsigned char*)T, r, lane); continue; } r -= I_KV;
            if (r < I_BIN) { p0_transpose_item_fp8(w_b_in, 8192, (unsigned char*)W_BIN, (LAS unsigned char*)T, r, lane); continue; } r -= I_BIN;
#else
            if (r < I_KV) { p0_transpose_item<0>(w_kv, 1024, W_KV, T, r, lane); continue; } r -= I_KV;
            if (r < I_BIN) { p0_transpose_item<0>(w_b_in, 8192, W_BIN, T, r, lane); continue; } r -= I_BIN;
#endif
#if USE_FP8_B >= 2
            p0_transpose_item_fp8(w_b_out, 4096, (unsigned char*)W_BOUT, (LAS unsigned char*)T, r, lane);
#else
            p0_transpose_item<0>(w_b_out, 4096, W_BOUT, T, r, lane);
#endif
        }
        if (BOTH(0)) GRID_BAR(0);
    }
    if (IN(1)) {
        LAS float* GS = (LAS float*)lds;
        for (int i = tid; i < D; i += NWAVES * 64) {
            const float sh = b_mod_a[i] + modp[MOD_A + i] + modp[NMOD + MOD_A + i];
            const float sc = b_mod_a[D + i] + modp[MOD_A + D + i] + modp[NMOD + MOD_A + D + i];
            GS[i] = g_a[i] * (1.0f + sc); GS[D + i] = sh; }
        for (int n = gtid; n < NMOD; n += gtotal) modv[n] = bcat(b_mod_a, b_mod_kv, b_mod_b, n) + modp[n] + modp[NMOD + n];
        __syncthreads();
        norm_rows_bf16<1>(x, HA, nullptr, GS, gw, NGW, lane);
        __syncthreads();
        if (BOTH(1)) GRID_BAR(1);
    }
    if (IN(2)) {
        pg8::Gemm g{HA, W_AIN, M, 4 * D, D}; pg8::StaticOrder S; S.init(M, 4 * D, G, bx);
#if USE_FUSED_CONV
        pg8::EpiConvGate E{YB, conv_a, CUH, BSH, PCH, (LAS float*)(lds + XCH_OFF)};
        pg8::gemm_phase<pg8::EpiConvGate, pg8::StaticOrder, true, true>(lds + RING_OFF, g, S, E);
#else
        pg8::EpiBf16S E{PROJ, 4 * D, 0, 0, 1.f, 0, 1.f};
        pg8::gemm_phase<pg8::EpiBf16S, pg8::StaticOrder, true, true>(lds + RING_OFF, g, S, E);
#endif
        if (BOTH(2)) GRID_BAR(2);
    }
    if (IN(3)) {
#if USE_FUSED_CONV
        conv_fixup(BSH, PCH, CUH, conv_a, YB, gtid, gtotal);
#else
        convgate_naive(PROJ, conv_a, YB, gtid, gtotal);
#endif
        if (BOTH(3)) GRID_BAR(3);
    }
    if (IN(4)) {
        pg8::Gemm g{YB, W_AOUT, M, D, D}; pg8::StaticOrder S; S.init(M, D, G, bx);
        pg8::EpiResGate E{x, X1, D, modv + MOD_A + 2 * D, 1.f};
        pg8::gemm_phase<pg8::EpiResGate, pg8::StaticOrder, true, true>(lds + RING_OFF, g, S, E);
        if (BOTH(4)) GRID_BAR(4);
    }
    if (IN(5)) {
        LAS float* GS = (LAS float*)lds;
        for (int i = tid; i < D; i += NWAVES * 64) {
            GS[i] = g_kv[i] * (1.0f + modv[MOD_KV + D + i]); GS[D + i] = modv[MOD_KV + i];
            GS[2 * D + i] = g_b[i] * (1.0f + modv[MOD_B + D + i]); GS[3 * D + i] = modv[MOD_B + i]; }
        __syncthreads();
#if USE_FP8_B >= 1
        norm_rows_fp8<2>(X1, (unsigned char*)HA, (unsigned char*)YB, GS, gw, NGW, lane);
#else
        norm_rows_bf16<2>(X1, HA, YB, GS, gw, NGW, lane);
#endif
        __syncthreads();
        if (BOTH(5)) GRID_BAR(5);
    }
    if (IN(6)) {
        constexpr bool F8 = (USE_FP8_B >= 1); constexpr int KK = F8 ? D / 2 : D; constexpr float PRE = F8 ? W8_INV : 1.0f;
        { pg8::Gemm g{HA, W_KV, M, 2 * KVD, KK}; pg8::StaticOrder S; S.init(M, 2 * KVD, G, bx);
          pg8::EpiBf16S E{KB, KVD, KVD, (size_t)(WS_V - WS_K) / 2, 1.f, 0, PRE};
          pg8::gemm_phase<pg8::EpiBf16S, pg8::StaticOrder, true, true, F8>(lds + RING_OFF, g, S, E); }
        { pg8::Gemm g{YB, W_BIN, M, 2 * D, KK}; pg8::StaticOrder S; S.init(M, 2 * D, G, bx);
          pg8::EpiBf16S E{QB, D, D, (size_t)(WS_Z - WS_Q) / 2, QSCALE, 1, PRE};
          pg8::gemm_phase<pg8::EpiBf16S, pg8::StaticOrder, true, true, F8>(lds + RING_OFF, g, S, E); }
        if (BOTH(6)) GRID_BAR(6);
    }
    if (IN(7)) {
#if USE_MFMA_ATTN
        swa::attn_phase(lds, QB, KB, VB, ZB, AG, rel_bias, sinks_b, vcu, G, tid, lane, wave);
#else
        attn_naive(lds, QB, KB, VB, ZB, AG, rel_bias, sinks_b, gtid, gtotal, tid);
#endif
        __syncthreads();
        if (BOTH(7)) GRID_BAR(7);
    }
    if (IN(8)) {
        pg8::Gemm g{AG, W_BOUT, M, D, D}; pg8::StaticOrder S; S.init(M, D, G, bx);
        pg8::EpiResGate E{X1, out, D, modv + MOD_B + 2 * D, 1.f};
        pg8::gemm_phase<pg8::EpiResGate, pg8::StaticOrder, true, true>(lds + RING_OFF, g, S, E);
        if (BOTH(8)) GRID_BAR(8);
    }
    if (IN(9)) {
        LAS float* GF = (LAS float*)lds;
        for (int i = tid; i < D; i += NWAVES * 64) GF[i] = g_final[i];
        __syncthreads();
        final_norm(out, GF, gw, NGW, lane);
    }
#undef IN
#undef BOTH
}

extern "C" void kernel_launch(void* const* d_in, const int* in_sizes, int n_in, void* d_out, int out_size, void* d_ws, size_t ws_size, hipStream_t stream) {
    static int grid = 0;
    if (grid == 0) {
        if (n_in != 20 || in_sizes[0] != M * D || out_size != M * D || ws_size < WS_END) { fprintf(stderr, "kernel_launch: built for 20 inputs, x/out of %d floats, >= %zu bytes of workspace; got n_in %d, in0 %d, out %d, ws %zu; nothing launched\n", M * D, (size_t)WS_END, n_in, n_in > 0 ? in_sizes[0] : -1, out_size, ws_size); grid = -1; return; }
        int dev = 0, cus = 0, per_cu = 0;
        if (hipGetDevice(&dev) != hipSuccess || hipDeviceGetAttribute(&cus, hipDeviceAttributeMultiprocessorCount, dev) != hipSuccess) { fprintf(stderr, "kernel_launch: hipGetDevice / hipDeviceGetAttribute failed\n"); grid = -1; return; }
        if (hipFuncSetAttribute((const void*)mk_fwd, hipFuncAttributeMaxDynamicSharedMemorySize, LDS_BYTES) != hipSuccess) { fprintf(stderr, "kernel_launch: hipFuncSetAttribute failed\n"); grid = -1; return; }
        if (hipOccupancyMaxActiveBlocksPerMultiprocessor(&per_cu, (const void*)mk_fwd, NWAVES * 64, LDS_BYTES) != hipSuccess || per_cu < 1)
            fprintf(stderr, "kernel_launch: note: the occupancy query reports %d workgroups per CU\n", per_cu);
        (void)hipGetLastError();
        grid = cus;
    }
    if (grid < 0) return;
    if (hipMemsetAsync((char*)d_ws + WS_CTL, 0, CTL_ZERO_BYTES, stream) != hipSuccess) { fprintf(stderr, "kernel_launch: hipMemsetAsync failed\n"); return; }
    Args a{};
    for (int i = 0; i < 20; ++i) a.in[i] = (const float*)d_in[i];
    a.out = (float*)d_out; a.ws = (unsigned char*)d_ws;
    for (int li = 0; li < N_LAUNCHES; ++li) {
        a.ph_lo = (N_LAUNCHES == 1) ? 0 : li; a.ph_hi = (N_LAUNCHES == 1) ? NPH : li + 1;
        hipLaunchKernelGGL(mk_fwd, dim3(grid), dim3(NWAVES * 64), LDS_BYTES, stream, a);
        const hipError_t le = hipPeekAtLastError();
        if (le != hipSuccess) { fprintf(stderr, "kernel_launch: launch %d failed: %s\n", li, hipGetErrorName(le)); break; }
    }
}
```

```cpp
#include <hip/hip_runtime.h>
#include <cstdio>
#include <cstdint>
namespace pg8 {
#define PG8_LAS __attribute__((address_space(3)))
typedef unsigned short bf16_t;
typedef short bf16x8 __attribute__((ext_vector_type(8)));
typedef float f32x4 __attribute__((ext_vector_type(4)));
typedef unsigned u32x4 __attribute__((ext_vector_type(4)));
constexpr int BM = 256, BK = 64, HALF = 128, HTB = HALF * BK * 2  , STAGE_BYTES = 8 * HTB, NXCD = 8, WGM = 8;

__host__ __device__ __forceinline__ int lds_byte(int r, int c) { const int st = (r >> 4) * 2 + (c >> 5), rr = r & 15, cc = c & 31, ob = rr * 64 + cc * 2; return st * 1024 + (ob ^ (((ob >> 9) & 1) << 5)); }
__host__ __device__ __forceinline__ void stage_rc(int b, int& R, int& C) { const int st = b / 1024, sb = b % 1024, swz = sb ^ (((sb >> 9) & 1) << 5); R = (st >> 1) * 16 + swz / 64; C = (st & 1) * 32 + (swz % 64) / 2; }
__host__ __device__ __forceinline__ int perm32(int rho) { const int n = rho >> 4, i = rho & 15; return 8 * (i >> 2) + 4 * n + (i & 3); }

struct Unit { int pm, pn; };
struct Gemm { const bf16_t* A; const bf16_t* Bt; int M, N, K; };

struct StaticOrder {
    int nM, nN, nwg, G, c;
    __host__ __device__ void init(int M, int N, int G_, int c_) { nM = M / BM; nN = N / BM; nwg = nM * nN; G = G_; c = c_; }
    __host__ __device__ bool next(int i, Unit& u) const {
        const long L = (long)i * G + c; if (L >= nwg) return false;
        int wgid = (int)L; { const int q = nwg / NXCD, r = nwg % NXCD, xcd = wgid % NXCD, off = wgid / NXCD; wgid = (xcd < r ? xcd * (q + 1) : r * (q + 1) + (xcd - r) * q) + off; }
        const int nig = WGM * nN, gid = wgid / nig, fm = gid * WGM, gsz = (nM - fm) < WGM ? (nM - fm) : WGM;
        u.pm = fm + ((wgid % nig) % gsz); u.pn = (wgid % nig) / gsz; return true;
    }
    __device__ __forceinline__ void a_ready(const Unit&) const {}
    __device__ __forceinline__ void done(const Unit&) const {}
};
__device__ __forceinline__ unsigned cvt_pk_bf16(float lo, float hi) { unsigned r; asm volatile("v_cvt_pk_bf16_f32 %0, %1, %2" : "=v"(r) : "v"(lo), "v"(hi)); return r; }
__device__ __forceinline__ float silu_f(float v) { return v * __builtin_amdgcn_rcpf(1.0f + __expf(-v)); }

struct EpiBf16S {
    static constexpr bool PERM = true, AFTER_DRAIN = false;
    bf16_t* O; int ldc; int split_cols; size_t split_stride; float scale0; int silu1; float pre;
    __device__ __forceinline__ void operator()(const f32x4 (&acc)[2][2][4][2], const Unit& u, int wr, int wc, int fr, int fq) const {
        const int row0 = u.pm * BM + wr * 64 + fr; int colt = u.pn * BM; bf16_t* base = O;
        float sc = 1.f; bool act = false;
        if (split_cols) { const int t = colt / split_cols; base += (size_t)t * split_stride; colt -= t * split_cols; if (t == 0) sc = scale0; else act = (silu1 != 0); }
        const int col0 = colt + wc * 32 + 8 * fq;
#pragma unroll
        for (int ai = 0; ai < 2; ++ai)
#pragma unroll
            for (int m = 0; m < 4; ++m) { bf16_t* rowp = base + (size_t)(row0 + ai * HALF + m * 16) * ldc + col0;
#pragma unroll
                for (int bj = 0; bj < 2; ++bj) { f32x4 v0 = acc[ai][bj][m][0] * pre, v1 = acc[ai][bj][m][1] * pre;
                    if (act) { v0 = (f32x4){silu_f(v0[0]), silu_f(v0[1]), silu_f(v0[2]), silu_f(v0[3])}; v1 = (f32x4){silu_f(v1[0]), silu_f(v1[1]), silu_f(v1[2]), silu_f(v1[3])}; }
                    v0 = v0 * sc; v1 = v1 * sc; u32x4 w; w.x = cvt_pk_bf16(v0[0], v0[1]); w.y = cvt_pk_bf16(v0[2], v0[3]); w.z = cvt_pk_bf16(v1[0], v1[1]); w.w = cvt_pk_bf16(v1[2], v1[3]);
                    *(u32x4*)(rowp + bj * HALF) = w; } }
    }
};

struct EpiResGate {
    static constexpr bool PERM = false, AFTER_DRAIN = false;
    const float* base; float* out; int ldc; const float* gate; float gmul;
    __device__ __forceinline__ void operator()(const f32x4 (&acc)[2][2][4][2], const Unit& u, int wr, int wc, int fr, int fq) const {
        const int col0 = u.pn * BM + wc * 32 + 4 * fq;
        f32x4 gv[2][2];
#pragma unroll
        for (int bj = 0; bj < 2; ++bj)
#pragma unroll
            for (int n = 0; n < 2; ++n) gv[bj][n] = *(const f32x4*)(gate + col0 + bj * HALF + n * 16) * gmul;
#pragma unroll
        for (int ai = 0; ai < 2; ++ai)
#pragma unroll
            for (int m = 0; m < 4; ++m) { const size_t off = (size_t)(u.pm * BM + ai * HALF + wr * 64 + m * 16 + fr) * ldc + col0;
#pragma unroll
                for (int bj = 0; bj < 2; ++bj)
#pragma unroll
                    for (int n = 0; n < 2; ++n) { const f32x4 bs = *(const f32x4*)(base + off + bj * HALF + n * 16);
                        *(f32x4*)(out + off + bj * HALF + n * 16) = bs + gv[bj][n] * acc[ai][bj][m][n]; }
                if (m & 1) asm volatile("" ::: "memory"); }
    }
};

template <int N> __device__ __forceinline__ float row_shr1(float v) { return __builtin_bit_cast(float, __builtin_amdgcn_update_dpp(0, __builtin_bit_cast(int, v), 0x110 + N, 0xf, 0xf, true)); }
template <int N> __device__ __forceinline__ f32x4 row_shr4(f32x4 v) {
    const float a = row_shr1<N>(v[0]), b = row_shr1<N>(v[1]), c = row_shr1<N>(v[2]), d = row_shr1<N>(v[3]);
    return (f32x4){a, b, c, d};
}
struct EpiConvGate {
    static constexpr bool PERM = true, AFTER_DRAIN = false;
    bf16_t* Y; const float* cw; float* CUH; float* BSH; float* PCH; PG8_LAS float* XCH;
    __device__ __forceinline__ void operator()(const f32x4 (&acc)[2][2][4][2], const Unit& u, int wr, int wc, int fr, int fq) const {
        const int chl = 16 * wc + 4 * fq, ch0 = 64 * u.pn + chl;
        f32x4 cu[2][4];
#pragma unroll
        for (int ai = 0; ai < 2; ++ai)
#pragma unroll
            for (int m = 0; m < 4; ++m) cu[ai][m] = acc[ai][0][m][1] * acc[ai][1][m][0];
        if (fr >= 14) {
#pragma unroll
            for (int ai = 0; ai < 2; ++ai)
#pragma unroll
                for (int m = 0; m < 4; ++m) *(PG8_LAS f32x4*)(XCH + ((8 * ai + 4 * wr + m) * 2 + (fr - 14)) * 64 + chl) = cu[ai][m];
            if (wr == 1) *(f32x4*)(CUH + ((size_t)u.pm * 2 + (fr - 14)) * 4096 + ch0) = cu[1][3];
        }
        const f32x4 w0 = *(const f32x4*)(cw + ch0), w1 = *(const f32x4*)(cw + 4096 + ch0), w2 = *(const f32x4*)(cw + 8192 + ch0);
        asm volatile("s_waitcnt lgkmcnt(0)" ::: "memory"); __builtin_amdgcn_s_barrier(); asm volatile("" ::: "memory");
#pragma unroll
        for (int ai = 0; ai < 2; ++ai)
#pragma unroll
            for (int m = 0; m < 4; ++m) {
                const int gi = 8 * ai + 4 * wr + m;
                f32x4 h0 = {0.f, 0.f, 0.f, 0.f}, h1 = h0;
                if (gi > 0 && fr < 2) { h0 = *(const PG8_LAS f32x4*)(XCH + ((gi - 1) * 2 + 0) * 64 + chl); h1 = *(const PG8_LAS f32x4*)(XCH + ((gi - 1) * 2 + 1) * 64 + chl); }
                f32x4 p1 = row_shr4<1>(cu[ai][m]), p2 = row_shr4<2>(cu[ai][m]);
                if (fr == 0) { p1 = h1; p2 = h0; } else if (fr == 1) { p2 = h1; }
                const f32x4 conv = w0 * p2 + w1 * p1 + w2 * cu[ai][m];
                const f32x4 b = acc[ai][0][m][0], z = acc[ai][1][m][1];
                const f32x4 bs = {b[0] * silu_f(z[0]), b[1] * silu_f(z[1]), b[2] * silu_f(z[2]), b[3] * silu_f(z[3])};
                const f32x4 y = bs * conv;
                const size_t row = (size_t)u.pm * BM + ai * HALF + wr * 64 + m * 16 + fr;
                typedef unsigned u32x2 __attribute__((ext_vector_type(2)));
                u32x2 w; w.x = cvt_pk_bf16(y[0], y[1]); w.y = cvt_pk_bf16(y[2], y[3]);
                *(u32x2*)(Y + row * 4096 + ch0) = w;
                if (gi == 0 && fr < 2) { *(f32x4*)(BSH + ((size_t)u.pm * 2 + fr) * 4096 + ch0) = bs; *(f32x4*)(PCH + ((size_t)u.pm * 2 + fr) * 4096 + ch0) = conv; }
            }
    }
};

template <class Epi, class Sched, bool ALIGN_EPI = false, bool SP2 = false, bool FP8 = false>
__device__ __forceinline__ void gemm_phase(PG8_LAS unsigned char* lds, const Gemm g, const Sched& S, const Epi& E) {
    const int tid = threadIdx.x, wid = __builtin_amdgcn_readfirstlane(tid >> 6), lane = tid & 63, wr = wid >> 2, wc = wid & 3, fr = lane & 15, fq = lane >> 4;
    const int K = g.K, nt = K / BK;
    unsigned voffA[2], voffB[2];
#pragma unroll
    for (int i = 0; i < 2; ++i) { int R, C; stage_rc(tid * 16 + i * 8192, R, C); const int Rb = Epi::PERM ? ((R & ~31) + perm32(R & 31)) : R;
        voffA[i] = (unsigned)(R * K + C) * 2u; voffB[i] = (unsigned)(Rb * K + C) * 2u; }
    const size_t kstep = (size_t)(BK * 2);
    const size_t hstep = (size_t)HALF * K * 2;
    const size_t tstep = 2 * hstep;
    const unsigned ldsw = (unsigned)wid * 1024u;
    const int aoff = lds_byte(wr * 64 + fr, fq * 8), boff = lds_byte(wc * 32 + fr, fq * 8);
#define PG8_SA(b, h) (((b) * 2 + (h)) * HTB)
#define PG8_SB(b, h) ((4 + (b) * 2 + (h)) * HTB)
#define PG8_STAGE(bufoff, gbase, voff) do { _Pragma("unroll") for (int _i = 0; _i < 2; ++_i) \
        __builtin_amdgcn_global_load_lds((const unsigned*)((const char*)(gbase) + (voff)[_i]), (PG8_LAS unsigned*)(lds + (bufoff) + ldsw + _i * 8192), 16, 0, 0); } while (0)
#define PG8_LD16(off) (*(const PG8_LAS bf16x8*)(lds + (off)))
#define PG8_CAT8(x, y) __builtin_shufflevector(__builtin_bit_cast(pg8_v4i, (x)), __builtin_bit_cast(pg8_v4i, (y)), 0, 1, 2, 3, 4, 5, 6, 7)
#define PG8_LDA(dst, b, h) do { if constexpr (FP8) { _Pragma("unroll") for (int m = 0; m < 4; ++m) dst##8[m] = PG8_CAT8(PG8_LD16(PG8_SA(b, h) + aoff + m * 2048), PG8_LD16(PG8_SA(b, h) + aoff + m * 2048 + 1024)); } \
        else { _Pragma("unroll") for (int m = 0; m < 4; ++m) _Pragma("unroll") for (int k = 0; k < 2; ++k) dst[m][k] = PG8_LD16(PG8_SA(b, h) + aoff + m * 2048 + k * 1024); } } while (0)
#define PG8_LDB(dst, b, h) do { if constexpr (FP8) { _Pragma("unroll") for (int n = 0; n < 2; ++n) dst##8[n] = PG8_CAT8(PG8_LD16(PG8_SB(b, h) + boff + n * 2048), PG8_LD16(PG8_SB(b, h) + boff + n * 2048 + 1024)); } \
        else { _Pragma("unroll") for (int n = 0; n < 2; ++n) _Pragma("unroll") for (int k = 0; k < 2; ++k) dst[n][k] = PG8_LD16(PG8_SB(b, h) + boff + n * 2048 + k * 1024); } } while (0)
#define PG8_MMA(ai, bj, At, Bt) do { __builtin_amdgcn_s_setprio(1); \
        if constexpr (FP8) { _Pragma("unroll") for (int m = 0; m < 4; ++m) _Pragma("unroll") for (int n = 0; n < 2; ++n) \
                asm volatile("v_mfma_scale_f32_16x16x128_f8f6f4 %0, %1, %2, %0, %3, %3 op_sel_hi:[0,0,0]" : "+v"(acc[ai][bj][m][n]) : "v"(Bt##8[n]), "v"(At##8[m]), "v"(pg8_one)); } \
        else { _Pragma("unroll") for (int m = 0; m < 4; ++m) _Pragma("unroll") for (int n = 0; n < 2; ++n) _Pragma("unroll") for (int k = 0; k < 2; ++k) \
        acc[ai][bj][m][n] = __builtin_amdgcn_mfma_f32_16x16x32_bf16(Bt[n][k], At[m][k], acc[ai][bj][m][n], 0, 0, 0); } __builtin_amdgcn_s_setprio(0); } while (0)
#define PG8_WAIT_V(n) asm volatile("s_waitcnt vmcnt(" #n ")" ::: "memory")
#define PG8_WAIT_L(n) asm volatile("s_waitcnt lgkmcnt(" #n ")" ::: "memory")
#define PG8_BAR __builtin_amdgcn_s_barrier()
#define PG8_SCHED __builtin_amdgcn_sched_barrier(0)
    Unit cur, nxt; int ui = 0;
    if (!S.next(0, cur)) return;
    f32x4 acc[2][2][4][2];
#pragma unroll
    for (int a = 0; a < 2; ++a)
#pragma unroll
        for (int b = 0; b < 2; ++b)
#pragma unroll
            for (int m = 0; m < 4; ++m)
#pragma unroll
                for (int n = 0; n < 2; ++n) acc[a][b][m][n] = (f32x4){0.f, 0.f, 0.f, 0.f};
    typedef int pg8_v8i __attribute__((ext_vector_type(8))); typedef int pg8_v4i __attribute__((ext_vector_type(4)));
    const int pg8_one = 0x7F7F7F7F;
    bf16x8 At[4][2], B0[2][2], B1[2][2]; pg8_v8i At8[4], B08[2], B18[2];
    const char* cA = (const char*)g.A + (size_t)cur.pm * tstep; const char* cB = (const char*)g.Bt + (size_t)cur.pn * tstep;
    S.a_ready(cur);
    if constexpr (SP2) {
        PG8_STAGE(PG8_SB(0, 0), cB, voffB); PG8_STAGE(PG8_SB(0, 1), cB + hstep, voffB); PG8_STAGE(PG8_SA(0, 0), cA, voffA); PG8_STAGE(PG8_SA(0, 1), cA + hstep, voffA);
        if (wr == 1) PG8_BAR;
        PG8_WAIT_V(2); PG8_BAR;
        PG8_STAGE(PG8_SB(1, 0), cB + kstep, voffB); PG8_STAGE(PG8_SA(1, 0), cA + kstep, voffA); PG8_STAGE(PG8_SB(1, 1), cB + hstep + kstep, voffB);
        PG8_WAIT_V(6); PG8_BAR;
    } else {
        PG8_STAGE(PG8_SB(0, 0), cB, voffB); PG8_STAGE(PG8_SA(0, 0), cA, voffA); PG8_STAGE(PG8_SB(0, 1), cB + hstep, voffB); PG8_STAGE(PG8_SA(0, 1), cA + hstep, voffA);
        if (wr == 1) PG8_BAR;
        PG8_WAIT_V(4); PG8_BAR;
        PG8_STAGE(PG8_SB(1, 0), cB + kstep, voffB); PG8_STAGE(PG8_SA(1, 0), cA + kstep, voffA); PG8_STAGE(PG8_SB(1, 1), cB + hstep + kstep, voffB);
        PG8_WAIT_V(6); PG8_BAR;
    }
    for (;;) {
        const bool has_next = S.next(ui + 1, nxt);
        const char* nA = has_next ? (const char*)g.A + (size_t)nxt.pm * tstep : cA; const char* nB = has_next ? (const char*)g.Bt + (size_t)nxt.pn * tstep : cB;
        for (int t = 0; t < nt; t += 2) {
            const bool last = (t == nt - 2);
            const char* a1 = cA + (size_t)(t + 1) * kstep;
            const char* a2 = last ? nA : cA + (size_t)(t + 2) * kstep; const char* b2 = last ? nB : cB + (size_t)(t + 2) * kstep;
            const char* a3 = a2 + kstep; const char* b3 = b2 + kstep;
            if (last && has_next) S.a_ready(nxt);
            if constexpr (SP2) {
            PG8_LDB(B0, 0, 0); PG8_LDB(B1, 0, 1); PG8_SCHED; PG8_LDA(At, 0, 0); PG8_STAGE(PG8_SA(1, 1), a1 + hstep, voffA);
            PG8_WAIT_V(8); PG8_WAIT_L(0); PG8_BAR; PG8_MMA(0, 0, At, B0); PG8_MMA(0, 1, At, B1); PG8_BAR; PG8_SCHED;
            PG8_LDA(At, 0, 1); PG8_STAGE(PG8_SB(0, 0), b2, voffB); PG8_STAGE(PG8_SB(0, 1), b2 + hstep, voffB); PG8_STAGE(PG8_SA(0, 0), a2, voffA);
            PG8_WAIT_V(8); PG8_WAIT_L(0); PG8_BAR; PG8_MMA(1, 0, At, B0); PG8_MMA(1, 1, At, B1); PG8_BAR; PG8_SCHED;
            PG8_LDB(B0, 1, 0); PG8_LDB(B1, 1, 1); PG8_SCHED; PG8_LDA(At, 1, 0); PG8_STAGE(PG8_SA(0, 1), a2 + hstep, voffA);
            PG8_WAIT_V(8); PG8_WAIT_L(0); PG8_BAR; PG8_MMA(0, 0, At, B0); PG8_MMA(0, 1, At, B1); PG8_BAR; PG8_SCHED;
            PG8_LDA(At, 1, 1); PG8_STAGE(PG8_SB(1, 0), b3, voffB); PG8_STAGE(PG8_SB(1, 1), b3 + hstep, voffB); PG8_STAGE(PG8_SA(1, 0), a3, voffA);
            PG8_WAIT_V(8); PG8_WAIT_L(0); PG8_BAR; PG8_MMA(1, 0, At, B0); PG8_MMA(1, 1, At, B1); PG8_BAR; PG8_SCHED;
            } else {
            PG8_LDB(B0, 0, 0); PG8_SCHED; PG8_LDA(At, 0, 0); PG8_STAGE(PG8_SA(1, 1), a1 + hstep, voffA);
            PG8_WAIT_L(8); PG8_BAR; PG8_WAIT_L(0); PG8_MMA(0, 0, At, B0); PG8_BAR; PG8_SCHED;
            PG8_LDB(B1, 0, 1); PG8_STAGE(PG8_SB(0, 0), b2, voffB);
            PG8_BAR; PG8_WAIT_L(0); PG8_MMA(0, 1, At, B1); PG8_BAR;
            PG8_LDA(At, 0, 1); PG8_STAGE(PG8_SA(0, 0), a2, voffA);
            PG8_BAR; PG8_WAIT_L(0); PG8_MMA(1, 0, At, B0); PG8_BAR; PG8_SCHED;
            PG8_STAGE(PG8_SB(0, 1), b2 + hstep, voffB);
            PG8_WAIT_V(6); PG8_BAR; PG8_MMA(1, 1, At, B1); PG8_BAR;
            PG8_LDB(B0, 1, 0); PG8_SCHED; PG8_LDA(At, 1, 0); PG8_STAGE(PG8_SA(0, 1), a2 + hstep, voffA);
            PG8_WAIT_L(8); PG8_BAR; PG8_WAIT_L(0); PG8_MMA(0, 0, At, B0); PG8_BAR; PG8_SCHED;
            PG8_LDB(B1, 1, 1); PG8_STAGE(PG8_SB(1, 0), b3, voffB);
            PG8_BAR; PG8_WAIT_L(0); PG8_MMA(0, 1, At, B1); PG8_BAR;
            PG8_LDA(At, 1, 1); PG8_STAGE(PG8_SA(1, 0), a3, voffA);
            PG8_BAR; PG8_WAIT_L(0); PG8_MMA(1, 0, At, B0); PG8_BAR; PG8_SCHED;
            PG8_STAGE(PG8_SB(1, 1), b3 + hstep, voffB);
            PG8_WAIT_V(6); PG8_BAR; PG8_MMA(1, 1, At, B1); PG8_BAR;
            }
        }
        if constexpr (ALIGN_EPI) { if (wr == 0) PG8_BAR; }
        if constexpr (FP8) asm volatile("s_nop 15\n\ts_nop 15" ::: "memory");
        if constexpr (!Epi::AFTER_DRAIN) { E(acc, cur, wr, wc, fr, fq); S.done(cur); }
        if (!has_next) break;
#pragma unroll
        for (int a = 0; a < 2; ++a)
#pragma unroll
            for (int b = 0; b < 2; ++b)
#pragma unroll
                for (int m = 0; m < 4; ++m)
#pragma unroll
                    for (int n = 0; n < 2; ++n) acc[a][b][m][n] = (f32x4){0.f, 0.f, 0.f, 0.f};
        cur = nxt; cA = nA; cB = nB; ++ui;
        if constexpr (ALIGN_EPI) { if (wr == 1) PG8_BAR; }
    }
    PG8_WAIT_V(0);
    if constexpr (!ALIGN_EPI) { if (wr == 0) PG8_BAR; }
    PG8_BAR;
    if constexpr (Epi::AFTER_DRAIN) { E.fused(acc, cur, wr, wc, fr, fq, lds, wid, lane); S.done(cur); }
#undef PG8_SA
#undef PG8_SB
#undef PG8_STAGE
#undef PG8_LDA
#undef PG8_LD16
#undef PG8_CAT8
#undef PG8_LDB
#undef PG8_MMA
#undef PG8_WAIT_V
#undef PG8_WAIT_L
#undef PG8_BAR
#undef PG8_SCHED
}
}
constexpr int NWAVES = 8;
#ifndef MK_N_LAUNCHES
#define MK_N_LAUNCHES 1
#endif
#ifndef USE_FUSED_CONV
#define USE_FUSED_CONV 1
#endif
#ifndef USE_MFMA_ATTN
#define USE_MFMA_ATTN 1
#endif
#ifndef USE_FP8_B
#define USE_FP8_B 2
#endif
#ifndef REP_P0
#define REP_P0 1
#endif
#ifndef REP_P7
#define REP_P7 1
#endif
constexpr int NPH = 10;
constexpr int N_LAUNCHES = MK_N_LAUNCHES;
static_assert(N_LAUNCHES == 1 || N_LAUNCHES == NPH, "MK_N_LAUNCHES is 1 or NPH");

constexpr int D = 4096, M = 16384, NH = 64, HD = 64, NKV = 8, KVD = NKV * HD, WIN = 128;
constexpr int NMOD = 32768;
constexpr int MOD_A = 0, MOD_KV = 12288, MOD_B = 20480;
constexpr float EPS = 1e-6f;
constexpr float LOG2E = 1.4426950408889634f;
constexpr float QSCALE = 0.125f * LOG2E;

constexpr size_t MiB = 1u << 20;
constexpr size_t WS_CTL = 0, CTL_ZERO_BYTES = 1 * MiB;
constexpr size_t WS_MODP = 1 * MiB;
constexpr size_t WS_MODV = 1 * MiB + 512 * 1024;
constexpr size_t WS_WAIN = 2 * MiB, WS_WAOUT = 130 * MiB, WS_WKV = 162 * MiB, WS_WBIN = 170 * MiB, WS_WBOUT = 234 * MiB;
constexpr size_t WS_HA = 266 * MiB;
constexpr size_t WS_Y = 394 * MiB;
constexpr size_t WS_X1 = 522 * MiB;
constexpr size_t WS_BIG = 778 * MiB;
constexpr size_t WS_Q = WS_BIG, WS_Z = WS_BIG + 128 * MiB, WS_AG = WS_BIG + 256 * MiB, WS_K = WS_BIG + 384 * MiB, WS_V = WS_BIG + 400 * MiB;
constexpr size_t WS_HALO = WS_BIG + 416 * MiB;
constexpr size_t WS_END = 1290 * MiB;
constexpr int CW_TMO = 0, CW_CODE = 1;
constexpr int CW_BAR = 4096;

constexpr int RING_OFF = 0, RING_BYTES = 131072;
constexpr int LDSCTL_OFF = RING_BYTES, MISC_OFF = LDSCTL_OFF + 320;
constexpr int XCH_OFF = LDSCTL_OFF + 1024;
constexpr int LDS_BYTES = 147456;
static_assert(XCH_OFF + 8192 <= LDS_BYTES, "LDS map");

#define GAS __attribute__((address_space(1)))
#define LAS __attribute__((address_space(3)))
typedef unsigned short bf16;
typedef unsigned v4u __attribute__((ext_vector_type(4)));
typedef unsigned v2u __attribute__((ext_vector_type(2)));
typedef float f32x4 __attribute__((ext_vector_type(4)));
typedef GAS unsigned gu32;
#define RLX_AGENT __ATOMIC_RELAXED, __HIP_MEMORY_SCOPE_AGENT
#define LDS_WAIT() asm volatile("s_waitcnt lgkmcnt(0)" ::: "memory")
#define VM_WAIT() asm volatile("s_waitcnt vmcnt(0)" ::: "memory")
__device__ __forceinline__ unsigned f2bf(float f) { unsigned u = __builtin_bit_cast(unsigned, f); return (u + 0x7fffu + ((u >> 16) & 1u)) >> 16; }
__device__ __forceinline__ unsigned pk2(float lo, float hi) { return f2bf(lo) | (f2bf(hi) << 16); }
__device__ __forceinline__ float bflo(unsigned w) { return __builtin_bit_cast(float, w << 16); }
__device__ __forceinline__ float bfhi(unsigned w) { return __builtin_bit_cast(float, w & 0xffff0000u); }
__device__ __forceinline__ unsigned pk4_fp8(float a, float b, float c, float d) { int w = 0; w = __builtin_amdgcn_cvt_pk_fp8_f32(a, b, w, false); w = __builtin_amdgcn_cvt_pk_fp8_f32(c, d, w, true); return (unsigned)w; }
constexpr float W8_SCALE = 256.0f, W8_INV = 1.0f / 256.0f;
__device__ __forceinline__ float silu(float v) { return v * __builtin_amdgcn_rcpf(1.0f + __expf(-v)); }

#define XB_TMO      128
#define XB_XCNT(j)  (256  + 64 * (j))
#define XB_XSUB(j)  (1280 + 64 * (j))
#define XB_XGEN(j)  (2304 + 64 * (j))
#define XB_TOP      3328
#define XB_TOPGEN   3392
#define XCD_BAR_WORDS 3456
#define XB_SPIN_CAP (1u << 18)

__device__ __forceinline__ unsigned xb_ld(unsigned* p)              { return __hip_atomic_load(p, __ATOMIC_RELAXED, __HIP_MEMORY_SCOPE_AGENT); }
__device__ __forceinline__ unsigned xb_add(unsigned* p, unsigned v) { return __hip_atomic_fetch_add(p, v, __ATOMIC_RELAXED, __HIP_MEMORY_SCOPE_AGENT); }
__device__ __forceinline__ unsigned xb_xcc_id() { return (unsigned)__builtin_amdgcn_s_getreg((3 << 11) | 20) & 0xFu; }
#define XB_SPIN(cond, bar) do { unsigned _sp = 0; while (cond) { __builtin_amdgcn_s_sleep(1); \
    if ((++_sp & 255u) == 0u) { if (xb_ld(&(bar)[XB_TMO])) break; if (_sp > XB_SPIN_CAP) { atomicAdd(&(bar)[XB_TMO], 1u); break; } } } } while (0)

struct XcdBarrier {
    unsigned* bar; unsigned x;
    volatile LAS unsigned* st;
};

__device__ __forceinline__ XcdBarrier xcd_barrier_post(unsigned* bar, volatile LAS unsigned* st) {
    XcdBarrier b; b.bar = bar; b.x = xb_xcc_id(); b.st = st;
    if (threadIdx.x == 0) (void)xb_add(&bar[XB_XCNT(b.x)], 1u);
    return b;
}
__device__ __forceinline__ void xcd_barrier_complete(unsigned* bar, unsigned x, unsigned& nloc, unsigned& nx) {
    const unsigned G = gridDim.x * gridDim.y * gridDim.z;
    unsigned sum, cnt, mine, sp = 0u;
    for (;;) {
        sum = 0u; cnt = 0u; mine = 0u;
#pragma unroll
        for (unsigned j = 0; j < 16; ++j) { const unsigned c = xb_ld(&bar[XB_XCNT(j)]); sum += c; cnt += (c > 0u) ? 1u : 0u; mine = (j == x) ? c : mine; }
        if (sum == G) break;
        __builtin_amdgcn_s_sleep(1);
        if ((++sp & 255u) == 0u) { if (xb_ld(&bar[XB_TMO])) break; if (sp > XB_SPIN_CAP) { atomicAdd(&bar[XB_TMO], 1u); break; } }
    }
    nloc = mine > 0u ? mine : 1u; nx = cnt > 0u ? cnt : 1u;
}

__device__ __forceinline__ void xcd_barrier(const XcdBarrier& b) {
    asm volatile("s_waitcnt vmcnt(0)" ::: "memory");
    __syncthreads();
    if (threadIdx.x == 0) {
        unsigned* bar = b.bar;
        __builtin_amdgcn_s_waitcnt(0);
        unsigned nloc = b.st[0], nx = b.st[1];
        if (nloc == 0u) { xcd_barrier_complete(bar, b.x, nloc, nx); b.st[0] = nloc; b.st[1] = nx; }
        const unsigned old = xb_add(&bar[XB_XSUB(b.x)], 1u);
        const unsigned gen = old / nloc;
        if (old + 1u == (gen + 1u) * nloc) {
            __builtin_amdgcn_fence(__ATOMIC_RELEASE, "agent");
            asm volatile("s_waitcnt vmcnt(0)" ::: "memory");
            const unsigned og = xb_add(&bar[XB_TOP], 1u);
            const unsigned tg = og / nx;
            if (og + 1u == (tg + 1u) * nx) xb_add(&bar[XB_TOPGEN], 1u);
            else XB_SPIN(xb_ld(&bar[XB_TOPGEN]) == tg, bar);
            __builtin_amdgcn_fence(__ATOMIC_ACQUIRE, "agent");
            xb_add(&bar[XB_XGEN(b.x)], 1u);
            asm volatile("s_waitcnt vmcnt(0)" ::: "memory");
        } else {
            XB_SPIN(xb_ld(&bar[XB_XGEN(b.x)]) == gen, bar);
            __builtin_amdgcn_fence(__ATOMIC_ACQUIRE, "agent");
            asm volatile("s_waitcnt vmcnt(0)" ::: "memory");
        }
    }
    __syncthreads();
}

__device__ __forceinline__ float wave_sum(float v) {
#pragma unroll
    for (int o = 1; o < 64; o <<= 1) v += __shfl_xor(v, o);
    return v;
}
__device__ __forceinline__ float bcat(const float* ba, const float* bkv, const float* bb, int n) { return n < MOD_KV ? ba[n] : (n < MOD_B ? bkv[n - MOD_KV] : bb[n - MOD_B]); }

__device__ __forceinline__ void p0_gemv(LAS unsigned char* lds, const float* c, const float* wa, const float* wkv, const float* wb, float* modp, int vcu, int G, int tid, int lane, int wave) {
    LAS float* SC = (LAS float*)lds;
    LAS float* RED = (LAS float*)(lds + 16384);
    for (int i = tid; i < D; i += NWAVES * 64) SC[i] = silu(c[i]);
    __syncthreads();
    for (int uu = vcu; uu < 256 * REP_P0; uu += G) {
        const int u = uu & 255, ch = u >> 1, kh = u & 1;
        const float* W; int pitch, col;
        if (ch < 48) { W = wa; pitch = 12288; col = ch * 256; } else if (ch < 80) { W = wkv; pitch = 8192; col = (ch - 48) * 256; } else { W = wb; pitch = 12288; col = (ch - 80) * 256; }
        const int k0 = kh * 2048 + wave * 256;
        const float* p = W + (size_t)k0 * pitch + col + 4 * lane;
        f32x4 a0 = {0.f, 0.f, 0.f, 0.f}, a1 = a0;
#pragma unroll 4
        for (int k = 0; k < 256; k += 2) {
            const f32x4 w0 = *(const f32x4*)(p + (size_t)k * pitch), w1 = *(const f32x4*)(p + (size_t)(k + 1) * pitch);
            a0 += w0 * SC[k0 + k]; a1 += w1 * SC[k0 + k + 1];
        }
        a0 += a1;
        *(LAS f32x4*)(RED + wave * 256 + 4 * lane) = a0;
        __syncthreads();
        if (tid < 256) { float s = 0.f;
#pragma unroll
            for (int w = 0; w < 8; ++w) s += RED[w * 256 + tid];
            modp[kh * NMOD + ch * 256 + tid] = s; }
        __syncthreads();
    }
}

template <int PERMUTE>
__device__ __forceinline__ void p0_transpose_item(const float* W, int N, bf16* WT, LAS unsigned short* T, int item, int lane) {
    const int nblk = N / 64, kb = item / nblk, nb = item % nblk, k0 = 64 * kb, n0 = 64 * nb;
    f32x4 v[16];
    const int kk0 = lane >> 4, nn = 4 * (lane & 15);
#pragma unroll
    for (int i = 0; i < 16; ++i) v[i] = *(const f32x4*)(W + (size_t)(k0 + 4 * i + kk0) * N + n0 + nn);
#pragma unroll
    for (int i = 0; i < 16; ++i) { const int kk = 4 * i + kk0;
        T[(nn + 0) * 72 + kk] = (unsigned short)f2bf(v[i][0]); T[(nn + 1) * 72 + kk] = (unsigned short)f2bf(v[i][1]);
        T[(nn + 2) * 72 + kk] = (unsigned short)f2bf(v[i][2]); T[(nn + 3) * 72 + kk] = (unsigned short)f2bf(v[i][3]); }
    LDS_WAIT(); asm volatile("" ::: "memory");
    const int c = lane & 7;
#pragma unroll
    for (int j = 0; j < 8; ++j) { const int n = (lane >> 3) + 8 * j;
        const v4u o = *(const LAS v4u*)(T + n * 72 + 8 * c);
        int nsrc = n0 + n, ndst = nsrc;
        if (PERMUTE) {
            const int q = nsrc >> 12, chn = nsrc & 4095;
            ndst = 256 * (chn >> 6) + 128 * (q >> 1) + 32 * ((chn >> 4) & 3) + 8 * ((chn >> 2) & 3) + 4 * (q & 1) + (chn & 3);
        }
        *(v4u*)(WT + (size_t)ndst * D + k0 + 8 * c) = o; }
    LDS_WAIT(); asm volatile("" ::: "memory");
}

__device__ __forceinline__ void p0_transpose_item_fp8(const float* W, int N, unsigned char* WT, LAS unsigned char* T, int item, int lane) {
    const int nblk = N / 32, kb = item / nblk, nb = item % nblk, k0 = 128 * kb, n0 = 32 * nb;
    f32x4 v[16];
    const int kk0 = lane >> 3, nn = 4 * (lane & 7);
#pragma unroll
    for (int i = 0; i < 16; ++i) v[i] = *(const f32x4*)(W + (size_t)(k0 + 8 * i + kk0) * N + n0 + nn);
#pragma unroll
    for (int i = 0; i < 16; ++i) { const int kk = 8 * i + kk0; const unsigned w = pk4_fp8(v[i][0] * W8_SCALE, v[i][1] * W8_SCALE, v[i][2] * W8_SCALE, v[i][3] * W8_SCALE);
        T[(nn + 0) * 144 + kk] = (unsigned char)(w & 0xffu); T[(nn + 1) * 144 + kk] = (unsigned char)((w >> 8) & 0xffu);
        T[(nn + 2) * 144 + kk] = (unsigned char)((w >> 16) & 0xffu); T[(nn + 3) * 144 + kk] = (unsigned char)(w >> 24); }
    LDS_WAIT(); asm volatile("" ::: "memory");
    const int c = lane & 7;
#pragma unroll
    for (int j = 0; j < 4; ++j) { const int n = (lane >> 3) + 8 * j;
        const v4u o = *(const LAS v4u*)(T + n * 144 + 16 * c);
        *(v4u*)(WT + (size_t)(n0 + n) * D + k0 + 16 * c) = o; }
    LDS_WAIT(); asm volatile("" ::: "memory");
}

template <int NOUT>
__device__ __forceinline__ void norm_rows_fp8(const float* X, unsigned char* O0, unsigned char* O1, const LAS float* GS, int gw, int NGW, int lane) {
    for (int m = gw; m < M; m += NGW) {
        asm volatile("" ::: "memory");
        const f32x4* xr = (const f32x4*)(X + (size_t)m * D) + 2 * lane;
        f32x4 v[8][2]; float s = 0.f;
#pragma unroll
        for (int j = 0; j < 8; ++j)
#pragma unroll
            for (int hh = 0; hh < 2; ++hh) { v[j][hh] = xr[128 * j + hh]; const f32x4 t = v[j][hh]; s += (t[0] * t[0] + t[1] * t[1]) + (t[2] * t[2] + t[3] * t[3]); }
        const float rstd = __builtin_amdgcn_rsqf(wave_sum(s) * (1.f / D) + EPS);
#pragma unroll
        for (int o = 0; o < NOUT; ++o) {
            v2u* op = (v2u*)((o == 0 ? O0 : O1) + (size_t)m * D) + lane;
#pragma unroll
            for (int j = 0; j < 8; ++j) {
                const int col = 512 * j + 8 * lane;
                const f32x4 ga = *(const LAS f32x4*)(GS + (o * 2 + 0) * D + col), gb = *(const LAS f32x4*)(GS + (o * 2 + 0) * D + col + 4);
                const f32x4 sa = *(const LAS f32x4*)(GS + (o * 2 + 1) * D + col), sb = *(const LAS f32x4*)(GS + (o * 2 + 1) * D + col + 4);
                const f32x4 ya = v[j][0] * rstd * ga + sa, yb = v[j][1] * rstd * gb + sb;
                v2u w; w.x = pk4_fp8(ya[0], ya[1], ya[2], ya[3]); w.y = pk4_fp8(yb[0], yb[1], yb[2], yb[3]); op[64 * j] = w; }
        }
    }
}

template <int NOUT>
__device__ __forceinline__ void norm_rows_bf16(const float* X, bf16* O0, bf16* O1, const LAS float* GS, int gw, int NGW, int lane) {
    for (int m = gw; m < M; m += NGW) {
        asm volatile("" ::: "memory");
        const f32x4* xr = (const f32x4*)(X + (size_t)m * D) + lane;
        f32x4 v[16]; float s = 0.f;
#pragma unroll
        for (int j = 0; j < 16; ++j) { v[j] = xr[64 * j]; s += (v[j][0] * v[j][0] + v[j][1] * v[j][1]) + (v[j][2] * v[j][2] + v[j][3] * v[j][3]); }
        const float rstd = __builtin_amdgcn_rsqf(wave_sum(s) * (1.f / D) + EPS);
#pragma unroll
        for (int o = 0; o < NOUT; ++o) {
            v2u* op = (v2u*)((o == 0 ? O0 : O1) + (size_t)m * D) + lane;
#pragma unroll
            for (int j = 0; j < 16; ++j) {
                const f32x4 g4 = *(const LAS f32x4*)(GS + (o * 2 + 0) * D + 256 * j + 4 * lane), s4 = *(const LAS f32x4*)(GS + (o * 2 + 1) * D + 256 * j + 4 * lane);
                const f32x4 y = v[j] * rstd * g4 + s4;
                v2u w; w.x = pk2(y[0], y[1]); w.y = pk2(y[2], y[3]); op[64 * j] = w; }
        }
    }
}

__device__ __forceinline__ void convgate_naive(const bf16* P, const float* cw, bf16* Y, int gtid, int total) {
    for (size_t idx = (size_t)gtid; idx < (size_t)M * 512; idx += (size_t)total) {
        const int t = (int)(idx >> 9), j = (int)(idx & 511) * 8;
        const bf16* r0 = P + (size_t)t * 16384 + j;
        const v4u zero = {0u, 0u, 0u, 0u};
        const v4u bq = *(const v4u*)(r0), zq = *(const v4u*)(r0 + 12288);
        const v4u c0 = *(const v4u*)(r0 + 4096), u0 = *(const v4u*)(r0 + 8192);
        const v4u c1 = t >= 1 ? *(const v4u*)(r0 - 16384 + 4096) : zero, u1 = t >= 1 ? *(const v4u*)(r0 - 16384 + 8192) : zero;
        const v4u c2 = t >= 2 ? *(const v4u*)(r0 - 32768 + 4096) : zero, u2 = t >= 2 ? *(const v4u*)(r0 - 32768 + 8192) : zero;
        float w0[8], w1[8], w2[8];
#pragma unroll
        for (int e = 0; e < 8; e += 4) { const f32x4 a = *(const f32x4*)(cw + j + e), b = *(const f32x4*)(cw + D + j + e), c = *(const f32x4*)(cw + 2 * D + j + e);
#pragma unroll
            for (int i = 0; i < 4; ++i) { w0[e + i] = a[i]; w1[e + i] = b[i]; w2[e + i] = c[i]; } }
        v4u o;
#pragma unroll
        for (int e = 0; e < 4; ++e) {
            float y[2];
#pragma unroll
            for (int hh = 0; hh < 2; ++hh) {
                const float b = hh ? bfhi(bq[e]) : bflo(bq[e]), z = hh ? bfhi(zq[e]) : bflo(zq[e]);
                const float cu0 = (hh ? bfhi(c0[e]) : bflo(c0[e])) * (hh ? bfhi(u0[e]) : bflo(u0[e]));
                const float cu1 = (hh ? bfhi(c1[e]) : bflo(c1[e])) * (hh ? bfhi(u1[e]) : bflo(u1[e]));
                const float cu2 = (hh ? bfhi(c2[e]) : bflo(c2[e])) * (hh ? bfhi(u2[e]) : bflo(u2[e]));
                const int ee = 2 * e + hh;
                y[hh] = b * (w0[ee] * cu2 + w1[ee] * cu1 + w2[ee] * cu0) * silu(z);
            }
            o[e] = pk2(y[0], y[1]);
        }
        *(v4u*)(Y + (size_t)t * D + j) = o;
    }
}

__device__ __forceinline__ int t5_bucket(int d) { if (d < 16) return d; const int b = 16 + (int)(__log2f((float)d * 0.0625f) * (16.0f / 3.0f)); return b < 31 ? b : 31; }

__device__ __forceinline__ void attn_naive(LAS unsigned char* lds, const bf16* Q, const bf16* K, const bf16* V, const bf16* Z, bf16* O, const float* rel_bias, const float* sinks, int gtid, int total, int tid) {
    LAS float* BT = (LAS float*)lds;
    for (int i = tid; i < NH * WIN; i += NWAVES * 64) { const int h = i >> 7, d = i & 127; BT[i] = rel_bias[t5_bucket(d) * NH + h] * LOG2E; }
    __syncthreads();
    for (int idx = gtid; idx < M * NH; idx += total) {
        const int h = idx >> 14, t = idx & (M - 1), g = h >> 3;
        float q[64], acc[64];
        { const v4u* qp = (const v4u*)(Q + (size_t)t * D + h * 64);
#pragma unroll
          for (int c = 0; c < 8; ++c) { const v4u w = qp[c];
#pragma unroll
              for (int e = 0; e < 4; ++e) { q[8 * c + 2 * e] = bflo(w[e]); q[8 * c + 2 * e + 1] = bfhi(w[e]); } } }
#pragma unroll
        for (int d = 0; d < 64; ++d) acc[d] = 0.f;
        float mx = sinks[h] * LOG2E, l = 1.f;
        const int nd = t < WIN - 1 ? t : WIN - 1;
        for (int i = 0; i <= nd; ++i) {
            const int s = t - i;
            const v4u* kp = (const v4u*)(K + (size_t)s * KVD + g * 64);
            float dot = 0.f;
#pragma unroll
            for (int c = 0; c < 8; ++c) { const v4u w = kp[c];
#pragma unroll
                for (int e = 0; e < 4; ++e) { dot += q[8 * c + 2 * e] * bflo(w[e]); dot += q[8 * c + 2 * e + 1] * bfhi(w[e]); } }
            const float lg = dot + BT[h * WIN + i];
            const float mn = fmaxf(mx, lg), f = __builtin_amdgcn_exp2f(mx - mn), p = __builtin_amdgcn_exp2f(lg - mn);
            l = l * f + p; mx = mn;
            const v4u* vp = (const v4u*)(V + (size_t)s * KVD + g * 64);
#pragma unroll
            for (int c = 0; c < 8; ++c) { const v4u w = vp[c];
#pragma unroll
                for (int e = 0; e < 4; ++e) { acc[8 * c + 2 * e] = acc[8 * c + 2 * e] * f + p * bflo(w[e]); acc[8 * c + 2 * e + 1] = acc[8 * c + 2 * e + 1] * f + p * bfhi(w[e]); } }
        }
        const float inv = 1.0f / l;
        const v4u* zp = (const v4u*)(Z + (size_t)t * D + h * 64); v4u* op = (v4u*)(O + (size_t)t * D + h * 64);
#pragma unroll
        for (int c = 0; c < 8; ++c) { const v4u w = zp[c]; v4u o;
#pragma unroll
            for (int e = 0; e < 4; ++e) o[e] = pk2(acc[8 * c + 2 * e] * inv * bflo(w[e]), acc[8 * c + 2 * e + 1] * inv * bfhi(w[e]));
            op[c] = o; }
    }
}


__device__ __forceinline__ void conv_fixup(const float* BSH, const float* PCH, const float* CUH, const float* cw, bf16* Y, int gtid, int total) {
    for (int idx = gtid; idx < 63 * 2 * 1024; idx += total) {
        const int c4 = (idx & 1023) * 4, r = (idx >> 10) & 1, pm = (idx >> 11) + 1;
        const f32x4 bs = *(const f32x4*)(BSH + ((size_t)pm * 2 + r) * D + c4), pc = *(const f32x4*)(PCH + ((size_t)pm * 2 + r) * D + c4);
        const f32x4 w0 = *(const f32x4*)(cw + c4), w1 = *(const f32x4*)(cw + D + c4);
        const f32x4 cA = *(const f32x4*)(CUH + ((size_t)(pm - 1) * 2 + 0) * D + c4), cB = *(const f32x4*)(CUH + ((size_t)(pm - 1) * 2 + 1) * D + c4);
        const f32x4 extra = r == 0 ? w0 * cA + w1 * cB : w0 * cB;
        const f32x4 y = bs * (pc + extra);
        v2u w; w.x = pk2(y[0], y[1]); w.y = pk2(y[2], y[3]);
        *(v2u*)(Y + ((size_t)pm * 256 + r) * D + c4) = w;
    }
}

namespace swa {
typedef short bf16x8 __attribute__((ext_vector_type(8)));
typedef float f32x16 __attribute__((ext_vector_type(16)));
constexpr int KP = 144, VP = 520, SP = 144;
constexpr int LDS_K = 0, LDS_V = 256 * KP, LDS_BT = LDS_V + 64 * VP, LDS_ST = LDS_BT + 8 * WIN * 4, LDS_END = LDS_ST + NWAVES * 32 * SP;
constexpr float AG_SCALE = (USE_FP8_B >= 2) ? 8.0f : 1.0f;
static_assert(LDS_V % 16 == 0 && LDS_BT % 16 == 0 && LDS_ST % 16 == 0 && LDS_END <= RING_BYTES, "attention LDS map");
__device__ __forceinline__ int crow(int r, int hi) { return (r & 3) + 8 * (r >> 2) + 4 * hi; }
__device__ __forceinline__ void attn_phase(LAS unsigned char* lds, const bf16* Q, const bf16* K, const bf16* V, const bf16* Z, void* Ov, const float* rel_bias, const float* sinks, int vcu, int G, int tid, int lane, int wave) {
    LAS float* BT = (LAS float*)(lds + LDS_BT);
    const int al = lane & 31, hi = lane >> 5;
    LAS unsigned short* vt = (LAS unsigned short*)(lds + LDS_V);
    LAS unsigned char* st = lds + LDS_ST + wave * (32 * SP);
    for (int uu = vcu; uu < (M / 128) * NKV * REP_P7; uu += G) {
        const int u = uu % ((M / 128) * NKV), qb = u >> 3, g = u & 7, h = 8 * g + wave;
        __syncthreads();
#pragma unroll
        for (int j = 0; j < 4; ++j) {
            const int idx = tid + NWAVES * 64 * j, key = idx >> 3, ch = idx & 7, pos = 128 * (qb - 1) + key;
            v4u kv = {0u, 0u, 0u, 0u}, vv = kv;
            if (pos >= 0) { kv = *(const v4u*)(K + (size_t)pos * KVD + g * 64 + ch * 8); vv = *(const v4u*)(V + (size_t)pos * KVD + g * 64 + ch * 8); }
            *(LAS v4u*)(lds + LDS_K + key * KP + ch * 16) = kv;
#pragma unroll
            for (int e = 0; e < 4; ++e) { vt[(ch * 8 + 2 * e) * (VP / 2) + key] = (unsigned short)(vv[e] & 0xffffu); vt[(ch * 8 + 2 * e + 1) * (VP / 2) + key] = (unsigned short)(vv[e] >> 16); }
        }
#pragma unroll
        for (int j = 0; j < 2; ++j) { const int i = tid + NWAVES * 64 * j, hh = i >> 7, d = i & 127; BT[i] = rel_bias[t5_bucket(d) * NH + 8 * g + hh] * LOG2E; }
        __syncthreads();
        const float sink2 = sinks[h] * LOG2E;
        const LAS float* bt = BT + wave * WIN;
        bf16x8 qr[4];
        { const bf16* qp = Q + (size_t)(128 * qb + al) * D + h * 64 + 8 * hi;
#pragma unroll
          for (int s = 0; s < 4; ++s) qr[s] = *(const bf16x8*)(qp + 16 * s); }
#pragma nounroll
        for (int i = 0; i < 4; ++i) {
            const int t0 = 128 * qb + 32 * i;
            f32x16 S[5];
#pragma unroll
            for (int jj = 0; jj < 5; ++jj) {
                const LAS unsigned char* kp = lds + LDS_K + (32 * (i + jj) + al) * KP + hi * 16;
                f32x16 a = {0.f, 0.f, 0.f, 0.f, 0.f, 0.f, 0.f, 0.f, 0.f, 0.f, 0.f, 0.f, 0.f, 0.f, 0.f, 0.f};
#pragma unroll
                for (int s = 0; s < 4; ++s) { const bf16x8 kf = *(const LAS bf16x8*)(kp + s * 32); a = __builtin_amdgcn_mfma_f32_32x32x16_bf16(kf, qr[s], a, 0, 0, 0); }
                S[jj] = a;
            }
            if (i < 3) {
                const bf16* qp = Q + (size_t)(t0 + 32 + al) * D + h * 64 + 8 * hi;
#pragma unroll
                for (int s = 0; s < 4; ++s) qr[s] = *(const bf16x8*)(qp + 16 * s);
            }
            float mx = sink2;
#pragma unroll
            for (int jj = 0; jj < 5; ++jj) {
#pragma unroll
                for (int r = 0; r < 16; ++r) {
                    const int kr = crow(r, hi), dist = 128 - 32 * jj + al - kr, b = 32 * (i + jj) + kr;
                    const bool inband = (jj >= 1 && jj <= 3) ? true : (dist >= 0 && dist < WIN);
                    const bool valid = inband && (qb > 0 || b >= 128);
                    const float v = valid ? S[jj][r] + bt[dist & (WIN - 1)] : -INFINITY;
                    S[jj][r] = v; mx = fmaxf(mx, v);
                }
                asm volatile("" ::: "memory");
            }
            mx = fmaxf(mx, __shfl_xor(mx, 32));
            float l = 0.f;
            v4u P[5][2];
#pragma unroll
            for (int jj = 0; jj < 5; ++jj)
#pragma unroll
                for (int ks = 0; ks < 2; ++ks)
#pragma unroll
                    for (int e = 0; e < 4; ++e) {
                        const float p0 = __builtin_amdgcn_exp2f(S[jj][8 * ks + 2 * e] - mx), p1 = __builtin_amdgcn_exp2f(S[jj][8 * ks + 2 * e + 1] - mx);
                        l += p0 + p1; P[jj][ks][e] = pg8::cvt_pk_bf16(p0, p1);
                    }
            l += __shfl_xor(l, 32);
            l += __builtin_amdgcn_exp2f(sink2 - mx);
            const float inv = 1.0f / l;
            v4u zz[2][2];
#pragma unroll
            for (int ps = 0; ps < 2; ++ps) { const v4u* zp = (const v4u*)(Z + (size_t)(t0 + (lane >> 2) + 16 * ps) * D + h * 64 + (lane & 3) * 16); zz[ps][0] = zp[0]; zz[ps][1] = zp[1]; }
            f32x16 o[2];
            o[0] = (f32x16){0.f, 0.f, 0.f, 0.f, 0.f, 0.f, 0.f, 0.f, 0.f, 0.f, 0.f, 0.f, 0.f, 0.f, 0.f, 0.f}; o[1] = o[0];
#pragma unroll
            for (int jj = 0; jj < 5; ++jj)
#pragma unroll
                for (int ks = 0; ks < 2; ++ks) {
                    const bf16x8 pf = __builtin_bit_cast(bf16x8, P[jj][ks]);
                    const int kb = 32 * (i + jj) + 16 * ks + 4 * hi;
#pragma unroll
                    for (int db = 0; db < 2; ++db) {
                        const LAS unsigned char* vp = lds + LDS_V + (32 * db + al) * VP + kb * 2;
                        const v2u lo = *(const LAS v2u*)vp, hh = *(const LAS v2u*)(vp + 16);
                        const v4u vw = {lo.x, lo.y, hh.x, hh.y};
                        o[db] = __builtin_amdgcn_mfma_f32_32x32x16_bf16(__builtin_bit_cast(bf16x8, vw), pf, o[db], 0, 0, 0);
                    }
                }
#pragma unroll
            for (int db = 0; db < 2; ++db)
#pragma unroll
                for (int rq = 0; rq < 4; ++rq) {
                    v2u w; w.x = pg8::cvt_pk_bf16(o[db][4 * rq] * inv, o[db][4 * rq + 1] * inv); w.y = pg8::cvt_pk_bf16(o[db][4 * rq + 2] * inv, o[db][4 * rq + 3] * inv);
                    *(LAS v2u*)(st + al * SP + (32 * db + 8 * rq + 4 * hi) * 2) = w;
                }
            LDS_WAIT(); asm volatile("" ::: "memory");
#pragma unroll
            for (int ps = 0; ps < 2; ++ps) {
                const int row = (lane >> 2) + 16 * ps, c16 = (lane & 3) * 16;
                const v4u oa = *(const LAS v4u*)(st + row * SP + c16 * 2), ob = *(const LAS v4u*)(st + row * SP + c16 * 2 + 16);
                float y[16];
#pragma unroll
                for (int e = 0; e < 4; ++e) { y[2 * e] = bflo(oa[e]) * bflo(zz[ps][0][e]) * AG_SCALE; y[2 * e + 1] = bfhi(oa[e]) * bfhi(zz[ps][0][e]) * AG_SCALE;
                                              y[8 + 2 * e] = bflo(ob[e]) * bflo(zz[ps][1][e]) * AG_SCALE; y[8 + 2 * e + 1] = bfhi(ob[e]) * bfhi(zz[ps][1][e]) * AG_SCALE; }
                if (USE_FP8_B >= 2) {
                    v4u w;
#pragma unroll
                    for (int e = 0; e < 4; ++e) w[e] = pk4_fp8(y[4 * e], y[4 * e + 1], y[4 * e + 2], y[4 * e + 3]);
                    *(v4u*)((unsigned char*)Ov + (size_t)(t0 + row) * D + h * 64 + c16) = w;
                } else {
                    v4u w0, w1;
#pragma unroll
                    for (int e = 0; e < 4; ++e) { w0[e] = pk2(y[2 * e], y[2 * e + 1]); w1[e] = pk2(y[8 + 2 * e], y[8 + 2 * e + 1]); }
                    v4u* op = (v4u*)((bf16*)Ov + (size_t)(t0 + row) * D + h * 64 + c16); op[0] = w0; op[1] = w1;
                }
            }
            LDS_WAIT(); asm volatile("" ::: "memory");
        }
    }
}
}

__device__ __forceinline__ void final_norm(float* X, const LAS float* G, int gw, int NGW, int lane) {
    for (int m = gw; m < M; m += NGW) {
        asm volatile("" ::: "memory");
        f32x4* xr = (f32x4*)(X + (size_t)m * D) + lane;
        f32x4 v[16]; float s = 0.f;
#pragma unroll
        for (int j = 0; j < 16; ++j) { v[j] = xr[64 * j]; s += (v[j][0] * v[j][0] + v[j][1] * v[j][1]) + (v[j][2] * v[j][2] + v[j][3] * v[j][3]); }
        const float rstd = __builtin_amdgcn_rsqf(wave_sum(s) * (1.f / D) + EPS);
#pragma unroll
        for (int j = 0; j < 16; ++j) xr[64 * j] = v[j] * rstd * *(const LAS f32x4*)(G + 256 * j + 4 * lane);
    }
}

struct Args { const float* in[20]; float* out; unsigned char* ws; int ph_lo, ph_hi; };
static_assert(sizeof(Args) == 22 * 8 + 8, "Args has no padding");
__global__ void __launch_bounds__(NWAVES * 64, 2) mk_fwd(Args args) {
    extern __shared__ __attribute__((aligned(16))) unsigned char lds_raw[];
    LAS unsigned char* lds = (LAS unsigned char*)lds_raw;
    volatile LAS unsigned* MISC = (volatile LAS unsigned*)(lds + MISC_OFF);
    const int tid = threadIdx.x, lane = tid & 63, wave = __builtin_amdgcn_readfirstlane(tid >> 6);
    const int G = gridDim.x; const int bx = blockIdx.x; const int vcu = (G % 8 == 0) ? (bx % 8) * (G / 8) + bx / 8 : bx;
    const int gw = vcu * NWAVES + wave, NGW = G * NWAVES, gtid = bx * (NWAVES * 64) + tid, gtotal = G * NWAVES * 64;
    unsigned char* ws = args.ws;
    gu32* ctl = (gu32*)(ws + WS_CTL);
    const float* x = args.in[0]; const float* cvec = args.in[1]; const float* g_a = args.in[2]; const float* w_mod_a = args.in[3]; const float* b_mod_a = args.in[4];
    const float* w_a_in = args.in[5]; const float* conv_a = args.in[6]; const float* w_a_out = args.in[7]; const float* g_kv = args.in[8]; const float* w_mod_kv = args.in[9];
    const float* b_mod_kv = args.in[10]; const float* w_kv = args.in[11]; const float* rel_bias = args.in[12]; const float* g_b = args.in[13]; const float* w_mod_b = args.in[14];
    const float* b_mod_b = args.in[15]; const float* w_b_in = args.in[16]; const float* sinks_b = args.in[17]; const float* w_b_out = args.in[18]; const float* g_final = args.in[19];
    float* out = args.out;
    float* modp = (float*)(ws + WS_MODP); float* modv = (float*)(ws + WS_MODV);
    bf16* W_AIN = (bf16*)(ws + WS_WAIN); bf16* W_AOUT = (bf16*)(ws + WS_WAOUT); bf16* W_KV = (bf16*)(ws + WS_WKV); bf16* W_BIN = (bf16*)(ws + WS_WBIN); bf16* W_BOUT = (bf16*)(ws + WS_WBOUT);
    bf16* HA = (bf16*)(ws + WS_HA); bf16* YB = (bf16*)(ws + WS_Y); float* X1 = (float*)(ws + WS_X1); bf16* PROJ = (bf16*)(ws + WS_BIG);
    float* CUH = (float*)(ws + WS_HALO); float* BSH = (float*)(ws + WS_HALO + 2 * MiB); float* PCH = (float*)(ws + WS_HALO + 4 * MiB);
    bf16* QB = (bf16*)(ws + WS_Q); bf16* ZB = (bf16*)(ws + WS_Z); bf16* AG = (bf16*)(ws + WS_AG); bf16* KB = (bf16*)(ws + WS_K); bf16* VB = (bf16*)(ws + WS_V);

    for (int u = tid; u < (LDS_BYTES - LDSCTL_OFF) / 4; u += NWAVES * 64) ((LAS unsigned*)(lds + LDSCTL_OFF))[u] = 0u;
    __syncthreads();
    XcdBarrier bar; bar.bar = (unsigned*)(ctl + CW_BAR); bar.x = 0; bar.st = nullptr;
    if (N_LAUNCHES == 1) bar = xcd_barrier_post((unsigned*)(ctl + CW_BAR), MISC + 8);
#define GRID_BAR(seam) do { if (N_LAUNCHES != 1) { if (tid == 0) __hip_atomic_store(ctl + CW_TMO, 0xBADBA0u | (unsigned)(seam), RLX_AGENT); } else { xcd_barrier(bar); } } while (0)
    const int lo = args.ph_lo, hi = args.ph_hi;
#define IN(k) (lo <= (k) && (k) < hi)
#define BOTH(k) (IN(k) && IN((k) + 1))

    if (IN(0)) {
        p0_gemv(lds, cvec, w_mod_a, w_mod_kv, w_mod_b, modp, vcu, G, tid, lane, wave);
        LAS unsigned short* T = (LAS unsigned short*)(lds + wave * 9216);
        constexpr int I_AIN = 64 * 256, I_AOUT = 64 * 64, I_KV = 64 * 16, I_BIN = 64 * 128, I_BOUT = 64 * 64, NITEMS = I_AIN + I_AOUT + I_KV + I_BIN + I_BOUT;
        for (int it = gw; it < NITEMS * REP_P0; it += NGW) {
            int r = it % NITEMS;
            if (r < I_AIN) { p0_transpose_item<USE_FUSED_CONV>(w_a_in, 16384, W_AIN, T, r, lane); continue; } r -= I_AIN;
            if (r < I_AOUT) { p0_transpose_item<0>(w_a_out, 4096, W_AOUT, T, r, lane); continue; } r -= I_AOUT;
#if USE_FP8_B >= 1
            if (r < I_KV) { p0_transpose_item_fp8(w_kv, 1024, (unsigned char*)W_KV, (LAS unsigned char*)T, r, lane); continue; } r -= I_KV;
            if (r < I_BIN) { p0_transpose_item_fp8(w_b_in, 8192, (unsigned char*)W_BIN, (LAS unsigned char*)T, r, lane); continue; } r -= I_BIN;
#else
            if (r < I_KV) { p0_transpose_item<0>(w_kv, 1024, W_KV, T, r, lane); continue; } r -= I_KV;
            if (r < I_BIN) { p0_transpose_item<0>(w_b_in, 8192, W_BIN, T, r, lane); continue; } r -= I_BIN;
#endif
#if USE_FP8_B >= 2
            p0_transpose_item_fp8(w_b_out, 4096, (unsigned char*)W_BOUT, (LAS unsigned char*)T, r, lane);
#else
            p0_transpose_item<0>(w_b_out, 4096, W_BOUT, T, r, lane);
#endif
        }
        if (BOTH(0)) GRID_BAR(0);
    }
    if (IN(1)) {
        LAS float* GS = (LAS float*)lds;
        for (int i = tid; i < D; i += NWAVES * 64) {
            const float sh = b_mod_a[i] + modp[MOD_A + i] + modp[NMOD + MOD_A + i];
            const float sc = b_mod_a[D + i] + modp[MOD_A + D + i] + modp[NMOD + MOD_A + D + i];
            GS[i] = g_a[i] * (1.0f + sc); GS[D + i] = sh; }
        for (int n = gtid; n < NMOD; n += gtotal) modv[n] = bcat(b_mod_a, b_mod_kv, b_mod_b, n) + modp[n] + modp[NMOD + n];
        __syncthreads();
        norm_rows_bf16<1>(x, HA, nullptr, GS, gw, NGW, lane);
        __syncthreads();
        if (BOTH(1)) GRID_BAR(1);
    }
    if (IN(2)) {
        pg8::Gemm g{HA, W_AIN, M, 4 * D, D}; pg8::StaticOrder S; S.init(M, 4 * D, G, bx);
#if USE_FUSED_CONV
        pg8::EpiConvGate E{YB, conv_a, CUH, BSH, PCH, (LAS float*)(lds + XCH_OFF)};
        pg8::gemm_phase<pg8::EpiConvGate, pg8::StaticOrder, true, true>(lds + RING_OFF, g, S, E);
#else
        pg8::EpiBf16S E{PROJ, 4 * D, 0, 0, 1.f, 0, 1.f};
        pg8::gemm_phase<pg8::EpiBf16S, pg8::StaticOrder, true, true>(lds + RING_OFF, g, S, E);
#endif
        if (BOTH(2)) GRID_BAR(2);
    }
    if (IN(3)) {
#if USE_FUSED_CONV
        conv_fixup(BSH, PCH, CUH, conv_a, YB, gtid, gtotal);
#else
        convgate_naive(PROJ, conv_a, YB, gtid, gtotal);
#endif
        if (BOTH(3)) GRID_BAR(3);
    }
    if (IN(4)) {
        pg8::Gemm g{YB, W_AOUT, M, D, D}; pg8::StaticOrder S; S.init(M, D, G, bx);
        pg8::EpiResGate E{x, X1, D, modv + MOD_A + 2 * D, 1.f};
        pg8::gemm_phase<pg8::EpiResGate, pg8::StaticOrder, true, true>(lds + RING_OFF, g, S, E);
        if (BOTH(4)) GRID_BAR(4);
    }
    if (IN(5)) {
        LAS float* GS = (LAS float*)lds;
        for (int i = tid; i < D; i += NWAVES * 64) {
            GS[i] = g_kv[i] * (1.0f + modv[MOD_KV + D + i]); GS[D + i] = modv[MOD_KV + i];
            GS[2 * D + i] = g_b[i] * (1.0f + modv[MOD_B + D + i]); GS[3 * D + i] = modv[MOD_B + i]; }
        __syncthreads();
#if USE_FP8_B >= 1
        norm_rows_fp8<2>(X1, (unsigned char*)HA, (unsigned char*)YB, GS, gw, NGW, lane);
#else
        norm_rows_bf16<2>(X1, HA, YB, GS, gw, NGW, lane);
#endif
        __syncthreads();
        if (BOTH(5)) GRID_BAR(5);
    }
    if (IN(6)) {
        constexpr bool F8 = (USE_FP8_B >= 1); constexpr int KK = F8 ? D / 2 : D; constexpr float PRE = F8 ? W8_INV : 1.0f;
        { pg8::Gemm g{HA, W_KV, M, 2 * KVD, KK}; pg8::StaticOrder S; S.init(M, 2 * KVD, G, bx);
          pg8::EpiBf16S E{KB, KVD, KVD, (size_t)(WS_V - WS_K) / 2, 1.f, 0, PRE};
          pg8::gemm_phase<pg8::EpiBf16S, pg8::StaticOrder, true, true, F8>(lds + RING_OFF, g, S, E); }
        { pg8::Gemm g{YB, W_BIN, M, 2 * D, KK}; pg8::StaticOrder S; S.init(M, 2 * D, G, bx);
          pg8::EpiBf16S E{QB, D, D, (size_t)(WS_Z - WS_Q) / 2, QSCALE, 1, PRE};
          pg8::gemm_phase<pg8::EpiBf16S, pg8::StaticOrder, true, true, F8>(lds + RING_OFF, g, S, E); }
        if (BOTH(6)) GRID_BAR(6);
    }
    if (IN(7)) {
#if USE_MFMA_ATTN
        swa::attn_phase(lds, QB, KB, VB, ZB, AG, rel_bias, sinks_b, vcu, G, tid, lane, wave);
#else
        attn_naive(lds, QB, KB, VB, ZB, AG, rel_bias, sinks_b, gtid, gtotal, tid);
#endif
        __syncthreads();
        if (BOTH(7)) GRID_BAR(7);
    }
    if (IN(8)) {
        constexpr bool F8 = (USE_FP8_B >= 2); constexpr int KK = F8 ? D / 2 : D; constexpr float GM = F8 ? W8_INV / swa::AG_SCALE : 1.0f;
        pg8::Gemm g{AG, W_BOUT, M, D, KK}; pg8::StaticOrder S; S.init(M, D, G, bx);
        pg8::EpiResGate E{X1, out, D, modv + MOD_B + 2 * D, GM};
        pg8::gemm_phase<pg8::EpiResGate, pg8::StaticOrder, true, true, F8>(lds + RING_OFF, g, S, E);
        if (BOTH(8)) GRID_BAR(8);
    }
    if (IN(9)) {
        LAS float* GF = (LAS float*)lds;
        for (int i = tid; i < D; i += NWAVES * 64) GF[i] = g_final[i];
        __syncthreads();
        final_norm(out, GF, gw, NGW, lane);
    }
#undef IN
#undef BOTH
}

extern "C" void kernel_launch(void* const* d_in, const int* in_sizes, int n_in, void* d_out, int out_size, void* d_ws, size_t ws_size, hipStream_t stream) {
    static int grid = 0;
    if (grid == 0) {
        if (n_in != 20 || in_sizes[0] != M * D || out_size != M * D || ws_size < WS_END) { fprintf(stderr, "kernel_launch: built for 20 inputs, x/out of %d floats, >= %zu bytes of workspace; got n_in %d, in0 %d, out %d, ws %zu; nothing launched\n", M * D, (size_t)WS_END, n_in, n_in > 0 ? in_sizes[0] : -1, out_size, ws_size); grid = -1; return; }
        int dev = 0, cus = 0, per_cu = 0;
        if (hipGetDevice(&dev) != hipSuccess || hipDeviceGetAttribute(&cus, hipDeviceAttributeMultiprocessorCount, dev) != hipSuccess) { fprintf(stderr, "kernel_launch: hipGetDevice / hipDeviceGetAttribute failed\n"); grid = -1; return; }
        if (hipFuncSetAttribute((const void*)mk_fwd, hipFuncAttributeMaxDynamicSharedMemorySize, LDS_BYTES) != hipSuccess) { fprintf(stderr, "kernel_launch: hipFuncSetAttribute failed\n"); grid = -1; return; }
        if (hipOccupancyMaxActiveBlocksPerMultiprocessor(&per_cu, (const void*)mk_fwd, NWAVES * 64, LDS_BYTES) != hipSuccess || per_cu < 1)
            fprintf(stderr, "kernel_launch: note: the occupancy query reports %d workgroups per CU\n", per_cu);
        (void)hipGetLastError();
        grid = cus;
    }
    if (grid < 0) return;
    if (hipMemsetAsync((char*)d_ws + WS_CTL, 0, CTL_ZERO_BYTES, stream) != hipSuccess) { fprintf(stderr, "kernel_launch: hipMemsetAsync failed\n"); return; }
    Args a{};
    for (int i = 0; i < 20; ++i) a.in[i] = (const float*)d_in[i];
    a.out = (float*)d_out; a.ws = (unsigned char*)d_ws;
    for (int li = 0; li < N_LAUNCHES; ++li) {
        a.ph_lo = (N_LAUNCHES == 1) ? 0 : li; a.ph_hi = (N_LAUNCHES == 1) ? NPH : li + 1;
        hipLaunchKernelGGL(mk_fwd, dim3(grid), dim3(NWAVES * 64), LDS_BYTES, stream, a);
        const hipError_t le = hipPeekAtLastError();
        if (le != hipSuccess) { fprintf(stderr, "kernel_launch: launch %d failed: %s\n", li, hipGetErrorName(le)); break; }
    }
}
```

```cpp
#include <hip/hip_runtime.h>
#include <cstdio>
#include <cstdint>
namespace pg8 {
#define PG8_LAS __attribute__((address_space(3)))
typedef unsigned short bf16_t;
typedef short bf16x8 __attribute__((ext_vector_type(8)));
typedef float f32x4 __attribute__((ext_vector_type(4)));
typedef unsigned u32x4 __attribute__((ext_vector_type(4)));
constexpr int BM = 256, BK = 64, HALF = 128, HTB = HALF * BK * 2  , STAGE_BYTES = 8 * HTB, NXCD = 8, WGM = 8;

__host__ __device__ __forceinline__ int lds_byte(int r, int c) { const int st = (r >> 4) * 2 + (c >> 5), rr = r & 15, cc = c & 31, ob = rr * 64 + cc * 2; return st * 1024 + (ob ^ (((ob >> 9) & 1) << 5)); }
__host__ __device__ __forceinline__ void stage_rc(int b, int& R, int& C) { const int st = b / 1024, sb = b % 1024, swz = sb ^ (((sb >> 9) & 1) << 5); R = (st >> 1) * 16 + swz / 64; C = (st & 1) * 32 + (swz % 64) / 2; }
__host__ __device__ __forceinline__ int perm32(int rho) { const int n = rho >> 4, i = rho & 15; return 8 * (i >> 2) + 4 * n + (i & 3); }

struct Unit { int pm, pn; };
struct Gemm { const bf16_t* A; const bf16_t* Bt; int M, N, K; };

struct StaticOrder {
    int nM, nN, nwg, G, c;
    __host__ __device__ void init(int M, int N, int G_, int c_) { nM = M / BM; nN = N / BM; nwg = nM * nN; G = G_; c = c_; }
    __host__ __device__ bool next(int i, Unit& u) const {
        const long L = (long)i * G + c; if (L >= nwg) return false;
        int wgid = (int)L; { const int q = nwg / NXCD, r = nwg % NXCD, xcd = wgid % NXCD, off = wgid / NXCD; wgid = (xcd < r ? xcd * (q + 1) : r * (q + 1) + (xcd - r) * q) + off; }
        const int nig = WGM * nN, gid = wgid / nig, fm = gid * WGM, gsz = (nM - fm) < WGM ? (nM - fm) : WGM;
        u.pm = fm + ((wgid % nig) % gsz); u.pn = (wgid % nig) / gsz; return true;
    }
    __device__ __forceinline__ void a_ready(const Unit&) const {}
    __device__ __forceinline__ void done(const Unit&) const {}
};
__device__ __forceinline__ unsigned cvt_pk_bf16(float lo, float hi) { unsigned r; asm volatile("v_cvt_pk_bf16_f32 %0, %1, %2" : "=v"(r) : "v"(lo), "v"(hi)); return r; }
__device__ __forceinline__ float silu_f(float v) { return v * __builtin_amdgcn_rcpf(1.0f + __expf(-v)); }

struct EpiBf16S {
    static constexpr bool PERM = true, AFTER_DRAIN = false;
    bf16_t* O; int ldc; int split_cols; size_t split_stride; float scale0; int silu1; float pre;
    __device__ __forceinline__ void operator()(const f32x4 (&acc)[2][2][4][2], const Unit& u, int wr, int wc, int fr, int fq) const {
        const int row0 = u.pm * BM + wr * 64 + fr; int colt = u.pn * BM; bf16_t* base = O;
        float sc = 1.f; bool act = false;
        if (split_cols) { const int t = colt / split_cols; base += (size_t)t * split_stride; colt -= t * split_cols; if (t == 0) sc = scale0; else act = (silu1 != 0); }
        const int col0 = colt + wc * 32 + 8 * fq;
#pragma unroll
        for (int ai = 0; ai < 2; ++ai)
#pragma unroll
            for (int m = 0; m < 4; ++m) { bf16_t* rowp = base + (size_t)(row0 + ai * HALF + m * 16) * ldc + col0;
#pragma unroll
                for (int bj = 0; bj < 2; ++bj) { f32x4 v0 = acc[ai][bj][m][0] * pre, v1 = acc[ai][bj][m][1] * pre;
                    if (act) { v0 = (f32x4){silu_f(v0[0]), silu_f(v0[1]), silu_f(v0[2]), silu_f(v0[3])}; v1 = (f32x4){silu_f(v1[0]), silu_f(v1[1]), silu_f(v1[2]), silu_f(v1[3])}; }
                    v0 = v0 * sc; v1 = v1 * sc; u32x4 w; w.x = cvt_pk_bf16(v0[0], v0[1]); w.y = cvt_pk_bf16(v0[2], v0[3]); w.z = cvt_pk_bf16(v1[0], v1[1]); w.w = cvt_pk_bf16(v1[2], v1[3]);
                    *(u32x4*)(rowp + bj * HALF) = w; } }
    }
};

struct EpiResGate {
    static constexpr bool PERM = false, AFTER_DRAIN = false;
    const float* base; float* out; int ldc; const float* gate; float gmul;
    __device__ __forceinline__ void operator()(const f32x4 (&acc)[2][2][4][2], const Unit& u, int wr, int wc, int fr, int fq) const {
        const int col0 = u.pn * BM + wc * 32 + 4 * fq;
        f32x4 gv[2][2];
#pragma unroll
        for (int bj = 0; bj < 2; ++bj)
#pragma unroll
            for (int n = 0; n < 2; ++n) gv[bj][n] = *(const f32x4*)(gate + col0 + bj * HALF + n * 16) * gmul;
        constexpr int RB = 3;
#pragma unroll
        for (int g0 = 0; g0 < 8; g0 += RB) {
            f32x4 bs[RB][2][2];
#pragma unroll
            for (int gg = 0; gg < RB; ++gg) if (g0 + gg < 8) { const int ai = (g0 + gg) >> 2, m = (g0 + gg) & 3; const size_t off = (size_t)(u.pm * BM + ai * HALF + wr * 64 + m * 16 + fr) * ldc + col0;
#pragma unroll
                for (int bj = 0; bj < 2; ++bj)
#pragma unroll
                    for (int n = 0; n < 2; ++n) bs[gg][bj][n] = *(const f32x4*)(base + off + bj * HALF + n * 16); }
#pragma unroll
            for (int gg = 0; gg < RB; ++gg) if (g0 + gg < 8) { const int ai = (g0 + gg) >> 2, m = (g0 + gg) & 3; const size_t off = (size_t)(u.pm * BM + ai * HALF + wr * 64 + m * 16 + fr) * ldc + col0;
#pragma unroll
                for (int bj = 0; bj < 2; ++bj)
#pragma unroll
                    for (int n = 0; n < 2; ++n) *(f32x4*)(out + off + bj * HALF + n * 16) = bs[gg][bj][n] + gv[bj][n] * acc[ai][bj][m][n]; }
            asm volatile("" ::: "memory");
        }
    }
};

struct RepOrder : StaticOrder { int rep;
    __device__ bool next(int i, Unit& u) const { const int per = nwg / G, r = rep < 0 ? -rep : rep; if (i >= per * r) return false;
        if (rep < 0 && i >= per) { u.pm = 0; u.pn = 0; return true; } return StaticOrder::next(i % per, u); } };

struct FixedOrder { int n;
    __device__ bool next(int i, Unit& u) const { if (i >= n) return false; u.pm = 0; u.pn = 0; return true; }
    __device__ __forceinline__ void a_ready(const Unit&) const {}
    __device__ __forceinline__ void done(const Unit&) const {} };

template <int N> __device__ __forceinline__ float row_shr1(float v) { return __builtin_bit_cast(float, __builtin_amdgcn_update_dpp(0, __builtin_bit_cast(int, v), 0x110 + N, 0xf, 0xf, true)); }
template <int N> __device__ __forceinline__ f32x4 row_shr4(f32x4 v) {
    const float a = row_shr1<N>(v[0]), b = row_shr1<N>(v[1]), c = row_shr1<N>(v[2]), d = row_shr1<N>(v[3]);
    return (f32x4){a, b, c, d};
}
struct EpiConvGate {
    static constexpr bool PERM = true, AFTER_DRAIN = false;
    bf16_t* Y; const float* cw; float* CUH; float* BSH; float* PCH; PG8_LAS float* XCH;
    __device__ __forceinline__ void operator()(const f32x4 (&acc)[2][2][4][2], const Unit& u, int wr, int wc, int fr, int fq) const {
        const int chl = 16 * wc + 4 * fq, ch0 = 64 * u.pn + chl;
        if (fr >= 14) {
#pragma unroll
            for (int ai = 0; ai < 2; ++ai)
#pragma unroll
                for (int m = 0; m < 4; ++m) *(PG8_LAS f32x4*)(XCH + ((8 * ai + 4 * wr + m) * 2 + (fr - 14)) * 64 + chl) = acc[ai][0][m][1] * acc[ai][1][m][0];
            if (wr == 1) *(f32x4*)(CUH + ((size_t)u.pm * 2 + (fr - 14)) * 4096 + ch0) = acc[1][0][3][1] * acc[1][1][3][0];
        }
        const f32x4 w0 = *(const f32x4*)(cw + ch0), w1 = *(const f32x4*)(cw + 4096 + ch0), w2 = *(const f32x4*)(cw + 8192 + ch0);
        asm volatile("s_waitcnt lgkmcnt(0)" ::: "memory"); __builtin_amdgcn_s_barrier(); asm volatile("" ::: "memory");
#pragma unroll
        for (int ai = 0; ai < 2; ++ai)
#pragma unroll
            for (int m = 0; m < 4; ++m) {
                const int gi = 8 * ai + 4 * wr + m;
                f32x4 h0 = {0.f, 0.f, 0.f, 0.f}, h1 = h0;
                if (gi > 0 && fr < 2) { h0 = *(const PG8_LAS f32x4*)(XCH + ((gi - 1) * 2 + 0) * 64 + chl); h1 = *(const PG8_LAS f32x4*)(XCH + ((gi - 1) * 2 + 1) * 64 + chl); }
                f32x4 cc = acc[ai][0][m][1]; asm volatile("" : "+v"(cc));
                const f32x4 cum = cc * acc[ai][1][m][0];
                f32x4 p1 = row_shr4<1>(cum), p2 = row_shr4<2>(cum);
                if (fr == 0) { p1 = h1; p2 = h0; } else if (fr == 1) { p2 = h1; }
                const f32x4 conv = w0 * p2 + w1 * p1 + w2 * cum;
                const f32x4 b = acc[ai][0][m][0], z = acc[ai][1][m][1];
                const f32x4 bs = {b[0] * silu_f(z[0]), b[1] * silu_f(z[1]), b[2] * silu_f(z[2]), b[3] * silu_f(z[3])};
                const f32x4 y = bs * conv;
                const size_t row = (size_t)u.pm * BM + ai * HALF + wr * 64 + m * 16 + fr;
                typedef unsigned u32x2 __attribute__((ext_vector_type(2)));
                u32x2 w; w.x = cvt_pk_bf16(y[0], y[1]); w.y = cvt_pk_bf16(y[2], y[3]);
                *(u32x2*)(Y + row * 4096 + ch0) = w;
                if (gi == 0 && fr < 2) { *(f32x4*)(BSH + ((size_t)u.pm * 2 + fr) * 4096 + ch0) = bs; *(f32x4*)(PCH + ((size_t)u.pm * 2 + fr) * 4096 + ch0) = conv; }
            }
    }
};

template <class Epi, class Sched, bool ALIGN_EPI = false, bool SP2 = false, bool FP8 = false>
__device__ __forceinline__ void gemm_phase(PG8_LAS unsigned char* lds, const Gemm g, const Sched& S, const Epi& E) {
    const int tid = threadIdx.x, wid = __builtin_amdgcn_readfirstlane(tid >> 6), lane = tid & 63, wr = wid >> 2, wc = wid & 3, fr = lane & 15, fq = lane >> 4;
    const int K = g.K, nt = K / BK;
    unsigned voffA[2], voffB[2];
#pragma unroll
    for (int i = 0; i < 2; ++i) { int R, C; stage_rc(tid * 16 + i * 8192, R, C); const int Rb = Epi::PERM ? ((R & ~31) + perm32(R & 31)) : R;
        voffA[i] = (unsigned)(R * K + C) * 2u; voffB[i] = (unsigned)(Rb * K + C) * 2u; }
    const size_t kstep = (size_t)(BK * 2);
    const size_t hstep = (size_t)HALF * K * 2;
    const size_t tstep = 2 * hstep;
    const unsigned ldsw = (unsigned)wid * 1024u;
    const int aoff = lds_byte(wr * 64 + fr, fq * 8), boff = lds_byte(wc * 32 + fr, fq * 8);
#define PG8_SA(b, h) (((b) * 2 + (h)) * HTB)
#define PG8_SB(b, h) ((4 + (b) * 2 + (h)) * HTB)
#define PG8_STAGE(bufoff, gbase, voff) do { _Pragma("unroll") for (int _i = 0; _i < 2; ++_i) \
        __builtin_amdgcn_global_load_lds((const unsigned*)((const char*)(gbase) + (voff)[_i]), (PG8_LAS unsigned*)(lds + (bufoff) + ldsw + _i * 8192), 16, 0, 0); } while (0)
#define PG8_LD16(off) (*(const PG8_LAS bf16x8*)(lds + (off)))
#define PG8_CAT8(x, y) __builtin_shufflevector(__builtin_bit_cast(pg8_v4i, (x)), __builtin_bit_cast(pg8_v4i, (y)), 0, 1, 2, 3, 4, 5, 6, 7)
#define PG8_LDA(dst, b, h) do { if constexpr (FP8) { _Pragma("unroll") for (int m = 0; m < 4; ++m) dst##8[m] = PG8_CAT8(PG8_LD16(PG8_SA(b, h) + aoff + m * 2048), PG8_LD16(PG8_SA(b, h) + aoff + m * 2048 + 1024)); } \
        else { _Pragma("unroll") for (int m = 0; m < 4; ++m) _Pragma("unroll") for (int k = 0; k < 2; ++k) dst[m][k] = PG8_LD16(PG8_SA(b, h) + aoff + m * 2048 + k * 1024); } } while (0)
#define PG8_LDB(dst, b, h) do { if constexpr (FP8) { _Pragma("unroll") for (int n = 0; n < 2; ++n) dst##8[n] = PG8_CAT8(PG8_LD16(PG8_SB(b, h) + boff + n * 2048), PG8_LD16(PG8_SB(b, h) + boff + n * 2048 + 1024)); } \
        else { _Pragma("unroll") for (int n = 0; n < 2; ++n) _Pragma("unroll") for (int k = 0; k < 2; ++k) dst[n][k] = PG8_LD16(PG8_SB(b, h) + boff + n * 2048 + k * 1024); } } while (0)
#define PG8_MMA(ai, bj, At, Bt) do { __builtin_amdgcn_s_setprio(1); \
        if constexpr (FP8) { _Pragma("unroll") for (int m = 0; m < 4; ++m) _Pragma("unroll") for (int n = 0; n < 2; ++n) \
                asm volatile("v_mfma_scale_f32_16x16x128_f8f6f4 %0, %1, %2, %0, %3, %3 op_sel_hi:[0,0,0]" : "+v"(acc[ai][bj][m][n]) : "v"(Bt##8[n]), "v"(At##8[m]), "v"(pg8_one)); } \
        else { _Pragma("unroll") for (int m = 0; m < 4; ++m) _Pragma("unroll") for (int n = 0; n < 2; ++n) _Pragma("unroll") for (int k = 0; k < 2; ++k) \
        acc[ai][bj][m][n] = __builtin_amdgcn_mfma_f32_16x16x32_bf16(Bt[n][k], At[m][k], acc[ai][bj][m][n], 0, 0, 0); } __builtin_amdgcn_s_setprio(0); } while (0)
#define PG8_WAIT_V(n) asm volatile("s_waitcnt vmcnt(" #n ")" ::: "memory")
#define PG8_WAIT_L(n) asm volatile("s_waitcnt lgkmcnt(" #n ")" ::: "memory")
#define PG8_BAR __builtin_amdgcn_s_barrier()
#define PG8_SCHED __builtin_amdgcn_sched_barrier(0)
    Unit cur, nxt; int ui = 0;
    if (!S.next(0, cur)) return;
    f32x4 acc[2][2][4][2];
#pragma unroll
    for (int a = 0; a < 2; ++a)
#pragma unroll
        for (int b = 0; b < 2; ++b)
#pragma unroll
            for (int m = 0; m < 4; ++m)
#pragma unroll
                for (int n = 0; n < 2; ++n) acc[a][b][m][n] = (f32x4){0.f, 0.f, 0.f, 0.f};
    typedef int pg8_v8i __attribute__((ext_vector_type(8))); typedef int pg8_v4i __attribute__((ext_vector_type(4)));
    const int pg8_one = 0x7F7F7F7F;
    bf16x8 At[4][2], B0[2][2], B1[2][2]; pg8_v8i At8[4], B08[2], B18[2];
    const char* cA = (const char*)g.A + (size_t)cur.pm * tstep; const char* cB = (const char*)g.Bt + (size_t)cur.pn * tstep;
    S.a_ready(cur);
    if constexpr (SP2) {
        PG8_STAGE(PG8_SB(0, 0), cB, voffB); PG8_STAGE(PG8_SB(0, 1), cB + hstep, voffB); PG8_STAGE(PG8_SA(0, 0), cA, voffA); PG8_STAGE(PG8_SA(0, 1), cA + hstep, voffA);
        if (wr == 1) PG8_BAR;
        PG8_WAIT_V(2); PG8_BAR;
        PG8_STAGE(PG8_SB(1, 0), cB + kstep, voffB); PG8_STAGE(PG8_SA(1, 0), cA + kstep, voffA); PG8_STAGE(PG8_SB(1, 1), cB + hstep + kstep, voffB);
        PG8_WAIT_V(6); PG8_BAR;
    } else {
        PG8_STAGE(PG8_SB(0, 0), cB, voffB); PG8_STAGE(PG8_SA(0, 0), cA, voffA); PG8_STAGE(PG8_SB(0, 1), cB + hstep, voffB); PG8_STAGE(PG8_SA(0, 1), cA + hstep, voffA);
        if (wr == 1) PG8_BAR;
        PG8_WAIT_V(4); PG8_BAR;
        PG8_STAGE(PG8_SB(1, 0), cB + kstep, voffB); PG8_STAGE(PG8_SA(1, 0), cA + kstep, voffA); PG8_STAGE(PG8_SB(1, 1), cB + hstep + kstep, voffB);
        PG8_WAIT_V(6); PG8_BAR;
    }
    for (;;) {
        const bool has_next = S.next(ui + 1, nxt);
        const char* nA = has_next ? (const char*)g.A + (size_t)nxt.pm * tstep : cA; const char* nB = has_next ? (const char*)g.Bt + (size_t)nxt.pn * tstep : cB;
        for (int t = 0; t < nt; t += 2) {
            const bool last = (t == nt - 2);
            const char* a1 = cA + (size_t)(t + 1) * kstep;
            const char* a2 = last ? nA : cA + (size_t)(t + 2) * kstep; const char* b2 = last ? nB : cB + (size_t)(t + 2) * kstep;
            const char* a3 = a2 + kstep; const char* b3 = b2 + kstep;
            if (last && has_next) S.a_ready(nxt);
            if constexpr (SP2) {
            PG8_LDB(B0, 0, 0); PG8_LDB(B1, 0, 1); PG8_SCHED; PG8_LDA(At, 0, 0); PG8_STAGE(PG8_SA(1, 1), a1 + hstep, voffA);
            PG8_WAIT_V(8); PG8_WAIT_L(0); PG8_BAR; PG8_MMA(0, 0, At, B0); PG8_MMA(0, 1, At, B1); PG8_BAR; PG8_SCHED;
            PG8_LDA(At, 0, 1); PG8_STAGE(PG8_SB(0, 0), b2, voffB); PG8_STAGE(PG8_SB(0, 1), b2 + hstep, voffB); PG8_STAGE(PG8_SA(0, 0), a2, voffA);
            PG8_WAIT_V(8); PG8_WAIT_L(0); PG8_BAR; PG8_MMA(1, 0, At, B0); PG8_MMA(1, 1, At, B1); PG8_BAR; PG8_SCHED;
            PG8_LDB(B0, 1, 0); PG8_LDB(B1, 1, 1); PG8_SCHED; PG8_LDA(At, 1, 0); PG8_STAGE(PG8_SA(0, 1), a2 + hstep, voffA);
            PG8_WAIT_V(8); PG8_WAIT_L(0); PG8_BAR; PG8_MMA(0, 0, At, B0); PG8_MMA(0, 1, At, B1); PG8_BAR; PG8_SCHED;
            PG8_LDA(At, 1, 1); PG8_STAGE(PG8_SB(1, 0), b3, voffB); PG8_STAGE(PG8_SB(1, 1), b3 + hstep, voffB); PG8_STAGE(PG8_SA(1, 0), a3, voffA);
            PG8_WAIT_V(8); PG8_WAIT_L(0); PG8_BAR; PG8_MMA(1, 0, At, B0); PG8_MMA(1, 1, At, B1); PG8_BAR; PG8_SCHED;
            } else {
            PG8_LDB(B0, 0, 0); PG8_SCHED; PG8_LDA(At, 0, 0); PG8_STAGE(PG8_SA(1, 1), a1 + hstep, voffA);
            PG8_WAIT_L(8); PG8_BAR; PG8_WAIT_L(0); PG8_MMA(0, 0, At, B0); PG8_BAR; PG8_SCHED;
            PG8_LDB(B1, 0, 1); PG8_STAGE(PG8_SB(0, 0), b2, voffB);
            PG8_BAR; PG8_WAIT_L(0); PG8_MMA(0, 1, At, B1); PG8_BAR;
            PG8_LDA(At, 0, 1); PG8_STAGE(PG8_SA(0, 0), a2, voffA);
            PG8_BAR; PG8_WAIT_L(0); PG8_MMA(1, 0, At, B0); PG8_BAR; PG8_SCHED;
            PG8_STAGE(PG8_SB(0, 1), b2 + hstep, voffB);
            PG8_WAIT_V(6); PG8_BAR; PG8_MMA(1, 1, At, B1); PG8_BAR;
            PG8_LDB(B0, 1, 0); PG8_SCHED; PG8_LDA(At, 1, 0); PG8_STAGE(PG8_SA(0, 1), a2 + hstep, voffA);
            PG8_WAIT_L(8); PG8_BAR; PG8_WAIT_L(0); PG8_MMA(0, 0, At, B0); PG8_BAR; PG8_SCHED;
            PG8_LDB(B1, 1, 1); PG8_STAGE(PG8_SB(1, 0), b3, voffB);
            PG8_BAR; PG8_WAIT_L(0); PG8_MMA(0, 1, At, B1); PG8_BAR;
            PG8_LDA(At, 1, 1); PG8_STAGE(PG8_SA(1, 0), a3, voffA);
            PG8_BAR; PG8_WAIT_L(0); PG8_MMA(1, 0, At, B0); PG8_BAR; PG8_SCHED;
            PG8_STAGE(PG8_SB(1, 1), b3 + hstep, voffB);
            PG8_WAIT_V(6); PG8_BAR; PG8_MMA(1, 1, At, B1); PG8_BAR;
            }
        }
        if constexpr (ALIGN_EPI) { if (wr == 0) PG8_BAR; }
        if constexpr (FP8) asm volatile("s_nop 15\n\ts_nop 15" ::: "memory");
        if constexpr (!Epi::AFTER_DRAIN) { E(acc, cur, wr, wc, fr, fq); S.done(cur); }
        if (!has_next) break;
#pragma unroll
        for (int a = 0; a < 2; ++a)
#pragma unroll
            for (int b = 0; b < 2; ++b)
#pragma unroll
                for (int m = 0; m < 4; ++m)
#pragma unroll
                    for (int n = 0; n < 2; ++n) acc[a][b][m][n] = (f32x4){0.f, 0.f, 0.f, 0.f};
        cur = nxt; cA = nA; cB = nB; ++ui;
        if constexpr (ALIGN_EPI) { if (wr == 1) PG8_BAR; }
    }
    PG8_WAIT_V(0);
    if constexpr (!ALIGN_EPI) { if (wr == 0) PG8_BAR; }
    PG8_BAR;
    if constexpr (Epi::AFTER_DRAIN) { E.fused(acc, cur, wr, wc, fr, fq, lds, wid, lane); S.done(cur); }
#undef PG8_SA
#undef PG8_SB
#undef PG8_STAGE
#undef PG8_LDA
#undef PG8_LD16
#undef PG8_CAT8
#undef PG8_LDB
#undef PG8_MMA
#undef PG8_WAIT_V
#undef PG8_WAIT_L
#undef PG8_BAR
#undef PG8_SCHED
}
}
constexpr int NWAVES = 8;
#ifndef MK_N_LAUNCHES
#define MK_N_LAUNCHES 1
#endif
#ifndef USE_FUSED_CONV
#define USE_FUSED_CONV 1
#endif
#ifndef USE_MFMA_ATTN
#define USE_MFMA_ATTN 1
#endif
#ifndef USE_FP8_B
#define USE_FP8_B 2
#endif
#ifndef REP_P0
#define REP_P0 1
#endif
#ifndef REP_P2
#define REP_P2 1
#endif
#ifndef PROBE_L2GEMM
#define PROBE_L2GEMM 0
#endif
#ifndef ONLY_PHASE
#define ONLY_PHASE -1
#endif
#ifndef REP_P7
#define REP_P7 1
#endif
constexpr int NPH = 10;
constexpr int N_LAUNCHES = MK_N_LAUNCHES;
static_assert(N_LAUNCHES == 1 || N_LAUNCHES == NPH, "MK_N_LAUNCHES is 1 or NPH");

constexpr int D = 4096, M = 16384, NH = 64, HD = 64, NKV = 8, KVD = NKV * HD, WIN = 128;
constexpr int NMOD = 32768;
constexpr int MOD_A = 0, MOD_KV = 12288, MOD_B = 20480;
constexpr float EPS = 1e-6f;
constexpr float LOG2E = 1.4426950408889634f;
constexpr float QSCALE = 0.125f * LOG2E;

constexpr size_t MiB = 1u << 20;
constexpr size_t WS_CTL = 0, CTL_ZERO_BYTES = 1 * MiB;
constexpr size_t WS_MODP = 1 * MiB;
constexpr size_t WS_MODV = 1 * MiB + 512 * 1024;
constexpr size_t WS_WAIN = 2 * MiB, WS_WAOUT = 130 * MiB, WS_WKV = 162 * MiB, WS_WBIN = 170 * MiB, WS_WBOUT = 234 * MiB;
constexpr size_t WS_HA = 266 * MiB;
constexpr size_t WS_Y = 394 * MiB;
constexpr size_t WS_X1 = 522 * MiB;
constexpr size_t WS_BIG = 778 * MiB;
constexpr size_t WS_Q = WS_BIG, WS_Z = WS_BIG + 128 * MiB, WS_AG = WS_BIG + 256 * MiB, WS_K = WS_BIG + 384 * MiB, WS_V = WS_BIG + 400 * MiB;
constexpr size_t WS_HALO = WS_BIG + 416 * MiB;
constexpr size_t WS_END = 1290 * MiB;
constexpr int CW_TMO = 0, CW_CODE = 1;
constexpr int CW_BAR = 4096;

constexpr int RING_OFF = 0, RING_BYTES = 131072;
constexpr int LDSCTL_OFF = RING_BYTES, MISC_OFF = LDSCTL_OFF + 320;
constexpr int XCH_OFF = LDSCTL_OFF + 1024;
constexpr int LDS_BYTES = 147456;
static_assert(XCH_OFF + 8192 <= LDS_BYTES, "LDS map");

#define GAS __attribute__((address_space(1)))
#define LAS __attribute__((address_space(3)))
typedef unsigned short bf16;
typedef unsigned v4u __attribute__((ext_vector_type(4)));
typedef unsigned v2u __attribute__((ext_vector_type(2)));
typedef float f32x4 __attribute__((ext_vector_type(4)));
typedef GAS unsigned gu32;
#define RLX_AGENT __ATOMIC_RELAXED, __HIP_MEMORY_SCOPE_AGENT
#define LDS_WAIT() asm volatile("s_waitcnt lgkmcnt(0)" ::: "memory")
#define VM_WAIT() asm volatile("s_waitcnt vmcnt(0)" ::: "memory")
__device__ __forceinline__ unsigned f2bf(float f) { unsigned u = __builtin_bit_cast(unsigned, f); return (u + 0x7fffu + ((u >> 16) & 1u)) >> 16; }
__device__ __forceinline__ unsigned pk2(float lo, float hi) { return f2bf(lo) | (f2bf(hi) << 16); }
__device__ __forceinline__ float bflo(unsigned w) { return __builtin_bit_cast(float, w << 16); }
__device__ __forceinline__ float bfhi(unsigned w) { return __builtin_bit_cast(float, w & 0xffff0000u); }
__device__ __forceinline__ unsigned pk4_fp8(float a, float b, float c, float d) { int w = 0; w = __builtin_amdgcn_cvt_pk_fp8_f32(a, b, w, false); w = __builtin_amdgcn_cvt_pk_fp8_f32(c, d, w, true); return (unsigned)w; }
constexpr float W8_SCALE = 256.0f, W8_INV = 1.0f / 256.0f;
__device__ __forceinline__ float silu(float v) { return v * __builtin_amdgcn_rcpf(1.0f + __expf(-v)); }

#define XB_TMO      128
#define XB_XCNT(j)  (256  + 64 * (j))
#define XB_XSUB(j)  (1280 + 64 * (j))
#define XB_XGEN(j)  (2304 + 64 * (j))
#define XB_TOP      3328
#define XB_TOPGEN   3392
#define XCD_BAR_WORDS 3456
#define XB_SPIN_CAP (1u << 18)

__device__ __forceinline__ unsigned xb_ld(unsigned* p)              { return __hip_atomic_load(p, __ATOMIC_RELAXED, __HIP_MEMORY_SCOPE_AGENT); }
__device__ __forceinline__ unsigned xb_add(unsigned* p, unsigned v) { return __hip_atomic_fetch_add(p, v, __ATOMIC_RELAXED, __HIP_MEMORY_SCOPE_AGENT); }
__device__ __forceinline__ unsigned xb_xcc_id() { return (unsigned)__builtin_amdgcn_s_getreg((3 << 11) | 20) & 0xFu; }
#define XB_SPIN(cond, bar) do { unsigned _sp = 0; while (cond) { __builtin_amdgcn_s_sleep(1); \
    if ((++_sp & 255u) == 0u) { if (xb_ld(&(bar)[XB_TMO])) break; if (_sp > XB_SPIN_CAP) { atomicAdd(&(bar)[XB_TMO], 1u); break; } } } } while (0)

struct XcdBarrier {
    unsigned* bar; unsigned x;
    volatile LAS unsigned* st;
};

__device__ __forceinline__ XcdBarrier xcd_barrier_post(unsigned* bar, volatile LAS unsigned* st) {
    XcdBarrier b; b.bar = bar; b.x = xb_xcc_id(); b.st = st;
    if (threadIdx.x == 0) (void)xb_add(&bar[XB_XCNT(b.x)], 1u);
    return b;
}
__device__ __forceinline__ void xcd_barrier_complete(unsigned* bar, unsigned x, unsigned& nloc, unsigned& nx) {
    const unsigned G = gridDim.x * gridDim.y * gridDim.z;
    unsigned sum, cnt, mine, sp = 0u;
    for (;;) {
        sum = 0u; cnt = 0u; mine = 0u;
#pragma unroll
        for (unsigned j = 0; j < 16; ++j) { const unsigned c = xb_ld(&bar[XB_XCNT(j)]); sum += c; cnt += (c > 0u) ? 1u : 0u; mine = (j == x) ? c : mine; }
        if (sum == G) break;
        __builtin_amdgcn_s_sleep(1);
        if ((++sp & 255u) == 0u) { if (xb_ld(&bar[XB_TMO])) break; if (sp > XB_SPIN_CAP) { atomicAdd(&bar[XB_TMO], 1u); break; } }
    }
    nloc = mine > 0u ? mine : 1u; nx = cnt > 0u ? cnt : 1u;
}

__device__ __forceinline__ void xcd_barrier(const XcdBarrier& b) {
    asm volatile("s_waitcnt vmcnt(0)" ::: "memory");
    __syncthreads();
    if (threadIdx.x == 0) {
        unsigned* bar = b.bar;
        __builtin_amdgcn_s_waitcnt(0);
        unsigned nloc = b.st[0], nx = b.st[1];
        if (nloc == 0u) { xcd_barrier_complete(bar, b.x, nloc, nx); b.st[0] = nloc; b.st[1] = nx; }
        const unsigned old = xb_add(&bar[XB_XSUB(b.x)], 1u);
        const unsigned gen = old / nloc;
        if (old + 1u == (gen + 1u) * nloc) {
            __builtin_amdgcn_fence(__ATOMIC_RELEASE, "agent");
            asm volatile("s_waitcnt vmcnt(0)" ::: "memory");
            const unsigned og = xb_add(&bar[XB_TOP], 1u);
            const unsigned tg = og / nx;
            if (og + 1u == (tg + 1u) * nx) xb_add(&bar[XB_TOPGEN], 1u);
            else XB_SPIN(xb_ld(&bar[XB_TOPGEN]) == tg, bar);
            __builtin_amdgcn_fence(__ATOMIC_ACQUIRE, "agent");
            xb_add(&bar[XB_XGEN(b.x)], 1u);
            asm volatile("s_waitcnt vmcnt(0)" ::: "memory");
        } else {
            XB_SPIN(xb_ld(&bar[XB_XGEN(b.x)]) == gen, bar);
            __builtin_amdgcn_fence(__ATOMIC_ACQUIRE, "agent");
            asm volatile("s_waitcnt vmcnt(0)" ::: "memory");
        }
    }
    __syncthreads();
}

__device__ __forceinline__ float wave_sum(float v) {
#pragma unroll
    for (int o = 1; o < 64; o <<= 1) v += __shfl_xor(v, o);
    return v;
}
__device__ __forceinline__ float bcat(const float* ba, const float* bkv, const float* bb, int n) { return n < MOD_KV ? ba[n] : (n < MOD_B ? bkv[n - MOD_KV] : bb[n - MOD_B]); }

__device__ __forceinline__ void p0_gemv(LAS unsigned char* lds, const float* c, const float* wa, const float* wkv, const float* wb, float* modp, int vcu, int G, int tid, int lane, int wave) {
    LAS float* SC = (LAS float*)lds;
    LAS float* RED = (LAS float*)(lds + 16384);
    for (int i = tid; i < D; i += NWAVES * 64) SC[i] = silu(c[i]);
    __syncthreads();
    for (int uu = vcu; uu < 256 * REP_P0; uu += G) {
        const int u = uu & 255, ch = u >> 1, kh = u & 1;
        const float* W; int pitch, col;
        if (ch < 48) { W = wa; pitch = 12288; col = ch * 256; } else if (ch < 80) { W = wkv; pitch = 8192; col = (ch - 48) * 256; } else { W = wb; pitch = 12288; col = (ch - 80) * 256; }
        const int k0 = kh * 2048 + wave * 256;
        const float* p = W + (size_t)k0 * pitch + col + 4 * lane;
        f32x4 a0 = {0.f, 0.f, 0.f, 0.f}, a1 = a0;
#pragma unroll 4
        for (int k = 0; k < 256; k += 2) {
            const f32x4 w0 = *(const f32x4*)(p + (size_t)k * pitch), w1 = *(const f32x4*)(p + (size_t)(k + 1) * pitch);
            a0 += w0 * SC[k0 + k]; a1 += w1 * SC[k0 + k + 1];
        }
        a0 += a1;
        *(LAS f32x4*)(RED + wave * 256 + 4 * lane) = a0;
        __syncthreads();
        if (tid < 256) { float s = 0.f;
#pragma unroll
            for (int w = 0; w < 8; ++w) s += RED[w * 256 + tid];
            modp[kh * NMOD + ch * 256 + tid] = s; }
        __syncthreads();
    }
}

template <int PERMUTE>
__device__ __forceinline__ void p0_transpose_item(const float* W, int N, bf16* WT, LAS unsigned short* T, int item, int lane) {
    const int nblk = N / 64, kb = item / nblk, nb = item % nblk, k0 = 64 * kb, n0 = 64 * nb;
    f32x4 v[16];
    const int kk0 = lane >> 4, nn = 4 * (lane & 15);
#pragma unroll
    for (int i = 0; i < 16; ++i) v[i] = *(const f32x4*)(W + (size_t)(k0 + 4 * i + kk0) * N + n0 + nn);
#pragma unroll
    for (int i = 0; i < 16; ++i) { const int kk = 4 * i + kk0;
        T[(nn + 0) * 72 + kk] = (unsigned short)f2bf(v[i][0]); T[(nn + 1) * 72 + kk] = (unsigned short)f2bf(v[i][1]);
        T[(nn + 2) * 72 + kk] = (unsigned short)f2bf(v[i][2]); T[(nn + 3) * 72 + kk] = (unsigned short)f2bf(v[i][3]); }
    LDS_WAIT(); asm volatile("" ::: "memory");
    const int c = lane & 7;
#pragma unroll
    for (int j = 0; j < 8; ++j) { const int n = (lane >> 3) + 8 * j;
        const v4u o = *(const LAS v4u*)(T + n * 72 + 8 * c);
        int nsrc = n0 + n, ndst = nsrc;
        if (PERMUTE) {
            const int q = nsrc >> 12, chn = nsrc & 4095;
            ndst = 256 * (chn >> 6) + 128 * (q >> 1) + 32 * ((chn >> 4) & 3) + 8 * ((chn >> 2) & 3) + 4 * (q & 1) + (chn & 3);
        }
        *(v4u*)(WT + (size_t)ndst * D + k0 + 8 * c) = o; }
    LDS_WAIT(); asm volatile("" ::: "memory");
}

__device__ __forceinline__ void p0_transpose_item_fp8(const float* W, int N, unsigned char* WT, LAS unsigned char* T, int item, int lane) {
    const int nblk = N / 32, kb = item / nblk, nb = item % nblk, k0 = 128 * kb, n0 = 32 * nb;
    f32x4 v[16];
    const int kk0 = lane >> 3, nn = 4 * (lane & 7);
#pragma unroll
    for (int i = 0; i < 16; ++i) v[i] = *(const f32x4*)(W + (size_t)(k0 + 8 * i + kk0) * N + n0 + nn);
#pragma unroll
    for (int i = 0; i < 16; ++i) { const int kk = 8 * i + kk0; const unsigned w = pk4_fp8(v[i][0] * W8_SCALE, v[i][1] * W8_SCALE, v[i][2] * W8_SCALE, v[i][3] * W8_SCALE);
        T[(nn + 0) * 144 + kk] = (unsigned char)(w & 0xffu); T[(nn + 1) * 144 + kk] = (unsigned char)((w >> 8) & 0xffu);
        T[(nn + 2) * 144 + kk] = (unsigned char)((w >> 16) & 0xffu); T[(nn + 3) * 144 + kk] = (unsigned char)(w >> 24); }
    LDS_WAIT(); asm volatile("" ::: "memory");
    const int c = lane & 7;
#pragma unroll
    for (int j = 0; j < 4; ++j) { const int n = (lane >> 3) + 8 * j;
        const v4u o = *(const LAS v4u*)(T + n * 144 + 16 * c);
        *(v4u*)(WT + (size_t)(n0 + n) * D + k0 + 16 * c) = o; }
    LDS_WAIT(); asm volatile("" ::: "memory");
}

template <int NOUT>
__device__ __forceinline__ void norm_rows_fp8(const float* X, unsigned char* O0, unsigned char* O1, const LAS float* GS, int gw, int NGW, int lane) {
    for (int m = gw; m < M; m += NGW) {
        asm volatile("" ::: "memory");
        const f32x4* xr = (const f32x4*)(X + (size_t)m * D) + 2 * lane;
        f32x4 v[8][2]; float s = 0.f;
#pragma unroll
        for (int j = 0; j < 8; ++j)
#pragma unroll
            for (int hh = 0; hh < 2; ++hh) { v[j][hh] = xr[128 * j + hh]; const f32x4 t = v[j][hh]; s += (t[0] * t[0] + t[1] * t[1]) + (t[2] * t[2] + t[3] * t[3]); }
        const float rstd = __builtin_amdgcn_rsqf(wave_sum(s) * (1.f / D) + EPS);
#pragma unroll
        for (int o = 0; o < NOUT; ++o) {
            v2u* op = (v2u*)((o == 0 ? O0 : O1) + (size_t)m * D) + lane;
#pragma unroll
            for (int j = 0; j < 8; ++j) {
                const int col = 512 * j + 8 * lane;
                const f32x4 ga = *(const LAS f32x4*)(GS + (o * 2 + 0) * D + col), gb = *(const LAS f32x4*)(GS + (o * 2 + 0) * D + col + 4);
                const f32x4 sa = *(const LAS f32x4*)(GS + (o * 2 + 1) * D + col), sb = *(const LAS f32x4*)(GS + (o * 2 + 1) * D + col + 4);
                const f32x4 ya = v[j][0] * rstd * ga + sa, yb = v[j][1] * rstd * gb + sb;
                v2u w; w.x = pk4_fp8(ya[0], ya[1], ya[2], ya[3]); w.y = pk4_fp8(yb[0], yb[1], yb[2], yb[3]); op[64 * j] = w; }
        }
    }
}

template <int NOUT>
__device__ __forceinline__ void norm_rows_bf16(const float* X, bf16* O0, bf16* O1, const LAS float* GS, int gw, int NGW, int lane) {
    for (int m = gw; m < M; m += NGW) {
        asm volatile("" ::: "memory");
        const f32x4* xr = (const f32x4*)(X + (size_t)m * D) + lane;
        f32x4 v[16]; float s = 0.f;
#pragma unroll
        for (int j = 0; j < 16; ++j) { v[j] = xr[64 * j]; s += (v[j][0] * v[j][0] + v[j][1] * v[j][1]) + (v[j][2] * v[j][2] + v[j][3] * v[j][3]); }
        const float rstd = __builtin_amdgcn_rsqf(wave_sum(s) * (1.f / D) + EPS);
#pragma unroll
        for (int o = 0; o < NOUT; ++o) {
            v2u* op = (v2u*)((o == 0 ? O0 : O1) + (size_t)m * D) + lane;
#pragma unroll
            for (int j = 0; j < 16; ++j) {
                const f32x4 g4 = *(const LAS f32x4*)(GS + (o * 2 + 0) * D + 256 * j + 4 * lane), s4 = *(const LAS f32x4*)(GS + (o * 2 + 1) * D + 256 * j + 4 * lane);
                const f32x4 y = v[j] * rstd * g4 + s4;
                v2u w; w.x = pk2(y[0], y[1]); w.y = pk2(y[2], y[3]); op[64 * j] = w; }
        }
    }
}

__device__ __forceinline__ void convgate_naive(const bf16* P, const float* cw, bf16* Y, int gtid, int total) {
    for (size_t idx = (size_t)gtid; idx < (size_t)M * 512; idx += (size_t)total) {
        const int t = (int)(idx >> 9), j = (int)(idx & 511) * 8;
        const bf16* r0 = P + (size_t)t * 16384 + j;
        const v4u zero = {0u, 0u, 0u, 0u};
        const v4u bq = *(const v4u*)(r0), zq = *(const v4u*)(r0 + 12288);
        const v4u c0 = *(const v4u*)(r0 + 4096), u0 = *(const v4u*)(r0 + 8192);
        const v4u c1 = t >= 1 ? *(const v4u*)(r0 - 16384 + 4096) : zero, u1 = t >= 1 ? *(const v4u*)(r0 - 16384 + 8192) : zero;
        const v4u c2 = t >= 2 ? *(const v4u*)(r0 - 32768 + 4096) : zero, u2 = t >= 2 ? *(const v4u*)(r0 - 32768 + 8192) : zero;
        float w0[8], w1[8], w2[8];
#pragma unroll
        for (int e = 0; e < 8; e += 4) { const f32x4 a = *(const f32x4*)(cw + j + e), b = *(const f32x4*)(cw + D + j + e), c = *(const f32x4*)(cw + 2 * D + j + e);
#pragma unroll
            for (int i = 0; i < 4; ++i) { w0[e + i] = a[i]; w1[e + i] = b[i]; w2[e + i] = c[i]; } }
        v4u o;
#pragma unroll
        for (int e = 0; e < 4; ++e) {
            float y[2];
#pragma unroll
            for (int hh = 0; hh < 2; ++hh) {
                const float b = hh ? bfhi(bq[e]) : bflo(bq[e]), z = hh ? bfhi(zq[e]) : bflo(zq[e]);
                const float cu0 = (hh ? bfhi(c0[e]) : bflo(c0[e])) * (hh ? bfhi(u0[e]) : bflo(u0[e]));
                const float cu1 = (hh ? bfhi(c1[e]) : bflo(c1[e])) * (hh ? bfhi(u1[e]) : bflo(u1[e]));
                const float cu2 = (hh ? bfhi(c2[e]) : bflo(c2[e])) * (hh ? bfhi(u2[e]) : bflo(u2[e]));
                const int ee = 2 * e + hh;
                y[hh] = b * (w0[ee] * cu2 + w1[ee] * cu1 + w2[ee] * cu0) * silu(z);
            }
            o[e] = pk2(y[0], y[1]);
        }
        *(v4u*)(Y + (size_t)t * D + j) = o;
    }
}

__device__ __forceinline__ int t5_bucket(int d) { if (d < 16) return d; const int b = 16 + (int)(__log2f((float)d * 0.0625f) * (16.0f / 3.0f)); return b < 31 ? b : 31; }

__device__ __forceinline__ void attn_naive(LAS unsigned char* lds, const bf16* Q, const bf16* K, const bf16* V, const bf16* Z, bf16* O, const float* rel_bias, const float* sinks, int gtid, int total, int tid) {
    LAS float* BT = (LAS float*)lds;
    for (int i = tid; i < NH * WIN; i += NWAVES * 64) { const int h = i >> 7, d = i & 127; BT[i] = rel_bias[t5_bucket(d) * NH + h] * LOG2E; }
    __syncthreads();
    for (int idx = gtid; idx < M * NH; idx += total) {
        const int h = idx >> 14, t = idx & (M - 1), g = h >> 3;
        float q[64], acc[64];
        { const v4u* qp = (const v4u*)(Q + (size_t)t * D + h * 64);
#pragma unroll
          for (int c = 0; c < 8; ++c) { const v4u w = qp[c];
#pragma unroll
              for (int e = 0; e < 4; ++e) { q[8 * c + 2 * e] = bflo(w[e]); q[8 * c + 2 * e + 1] = bfhi(w[e]); } } }
#pragma unroll
        for (int d = 0; d < 64; ++d) acc[d] = 0.f;
        float mx = sinks[h] * LOG2E, l = 1.f;
        const int nd = t < WIN - 1 ? t : WIN - 1;
        for (int i = 0; i <= nd; ++i) {
            const int s = t - i;
            const v4u* kp = (const v4u*)(K + (size_t)s * KVD + g * 64);
            float dot = 0.f;
#pragma unroll
            for (int c = 0; c < 8; ++c) { const v4u w = kp[c];
#pragma unroll
                for (int e = 0; e < 4; ++e) { dot += q[8 * c + 2 * e] * bflo(w[e]); dot += q[8 * c + 2 * e + 1] * bfhi(w[e]); } }
            const float lg = dot + BT[h * WIN + i];
            const float mn = fmaxf(mx, lg), f = __builtin_amdgcn_exp2f(mx - mn), p = __builtin_amdgcn_exp2f(lg - mn);
            l = l * f + p; mx = mn;
            const v4u* vp = (const v4u*)(V + (size_t)s * KVD + g * 64);
#pragma unroll
            for (int c = 0; c < 8; ++c) { const v4u w = vp[c];
#pragma unroll
                for (int e = 0; e < 4; ++e) { acc[8 * c + 2 * e] = acc[8 * c + 2 * e] * f + p * bflo(w[e]); acc[8 * c + 2 * e + 1] = acc[8 * c + 2 * e + 1] * f + p * bfhi(w[e]); } }
        }
        const float inv = 1.0f / l;
        const v4u* zp = (const v4u*)(Z + (size_t)t * D + h * 64); v4u* op = (v4u*)(O + (size_t)t * D + h * 64);
#pragma unroll
        for (int c = 0; c < 8; ++c) { const v4u w = zp[c]; v4u o;
#pragma unroll
            for (int e = 0; e < 4; ++e) o[e] = pk2(acc[8 * c + 2 * e] * inv * bflo(w[e]), acc[8 * c + 2 * e + 1] * inv * bfhi(w[e]));
            op[c] = o; }
    }
}


__device__ __forceinline__ void conv_fixup(const float* BSH, const float* PCH, const float* CUH, const float* cw, bf16* Y, int gtid, int total) {
    for (int idx = gtid; idx < 63 * 2 * 1024; idx += total) {
        const int c4 = (idx & 1023) * 4, r = (idx >> 10) & 1, pm = (idx >> 11) + 1;
        const f32x4 bs = *(const f32x4*)(BSH + ((size_t)pm * 2 + r) * D + c4), pc = *(const f32x4*)(PCH + ((size_t)pm * 2 + r) * D + c4);
        const f32x4 w0 = *(const f32x4*)(cw + c4), w1 = *(const f32x4*)(cw + D + c4);
        const f32x4 cA = *(const f32x4*)(CUH + ((size_t)(pm - 1) * 2 + 0) * D + c4), cB = *(const f32x4*)(CUH + ((size_t)(pm - 1) * 2 + 1) * D + c4);
        const f32x4 extra = r == 0 ? w0 * cA + w1 * cB : w0 * cB;
        const f32x4 y = bs * (pc + extra);
        v2u w; w.x = pk2(y[0], y[1]); w.y = pk2(y[2], y[3]);
        *(v2u*)(Y + ((size_t)pm * 256 + r) * D + c4) = w;
    }
}

namespace swa {
typedef short bf16x8 __attribute__((ext_vector_type(8)));
typedef float f32x16 __attribute__((ext_vector_type(16)));
constexpr int KP = 144, VP = 520, SP = 144;
constexpr int LDS_K = 0, LDS_V = 256 * KP, LDS_BT = LDS_V + 64 * VP, LDS_ST = LDS_BT + 8 * WIN * 4, LDS_END = LDS_ST + NWAVES * 32 * SP;
constexpr float AG_SCALE = (USE_FP8_B >= 2) ? 8.0f : 1.0f;
static_assert(LDS_V % 16 == 0 && LDS_BT % 16 == 0 && LDS_ST % 16 == 0 && LDS_END <= RING_BYTES, "attention LDS map");
__device__ __forceinline__ int crow(int r, int hi) { return (r & 3) + 8 * (r >> 2) + 4 * hi; }
__device__ __forceinline__ void attn_phase(LAS unsigned char* lds, const bf16* Q, const bf16* K, const bf16* V, const bf16* Z, void* Ov, const float* rel_bias, const float* sinks, int vcu, int G, int tid, int lane, int wave) {
    LAS float* BT = (LAS float*)(lds + LDS_BT);
    const int al = lane & 31, hi = lane >> 5;
    LAS unsigned short* vt = (LAS unsigned short*)(lds + LDS_V);
    LAS unsigned char* st = lds + LDS_ST + wave * (32 * SP);
    for (int uu = vcu; uu < (M / 128) * NKV * REP_P7; uu += G) {
        const int u = uu % ((M / 128) * NKV), qb = u >> 3, g = u & 7, h = 8 * g + wave;
        __syncthreads();
#pragma unroll
        for (int j = 0; j < 4; ++j) {
            const int idx = tid + NWAVES * 64 * j, key = idx >> 3, ch = idx & 7, pos = 128 * (qb - 1) + key;
            v4u kv = {0u, 0u, 0u, 0u}, vv = kv;
            if (pos >= 0) { kv = *(const v4u*)(K + (size_t)pos * KVD + g * 64 + ch * 8); vv = *(const v4u*)(V + (size_t)pos * KVD + g * 64 + ch * 8); }
            *(LAS v4u*)(lds + LDS_K + key * KP + ch * 16) = kv;
#pragma unroll
            for (int e = 0; e < 4; ++e) { vt[(ch * 8 + 2 * e) * (VP / 2) + key] = (unsigned short)(vv[e] & 0xffffu); vt[(ch * 8 + 2 * e + 1) * (VP / 2) + key] = (unsigned short)(vv[e] >> 16); }
        }
#pragma unroll
        for (int j = 0; j < 2; ++j) { const int i = tid + NWAVES * 64 * j, hh = i >> 7, d = i & 127; BT[i] = rel_bias[t5_bucket(d) * NH + 8 * g + hh] * LOG2E; }
        __syncthreads();
        const float sink2 = sinks[h] * LOG2E;
        const LAS float* bt = BT + wave * WIN;
        bf16x8 qr[4];
        { const bf16* qp = Q + (size_t)(128 * qb + al) * D + h * 64 + 8 * hi;
#pragma unroll
          for (int s = 0; s < 4; ++s) qr[s] = *(const bf16x8*)(qp + 16 * s); }
#pragma nounroll
        for (int i = 0; i < 4; ++i) {
            const int t0 = 128 * qb + 32 * i;
            f32x16 S[5];
#pragma unroll
            for (int jj = 0; jj < 5; ++jj) {
                const LAS unsigned char* kp = lds + LDS_K + (32 * (i + jj) + al) * KP + hi * 16;
                f32x16 a = {0.f, 0.f, 0.f, 0.f, 0.f, 0.f, 0.f, 0.f, 0.f, 0.f, 0.f, 0.f, 0.f, 0.f, 0.f, 0.f};
#pragma unroll
                for (int s = 0; s < 4; ++s) { const bf16x8 kf = *(const LAS bf16x8*)(kp + s * 32); a = __builtin_amdgcn_mfma_f32_32x32x16_bf16(kf, qr[s], a, 0, 0, 0); }
                S[jj] = a;
            }
            if (i < 3) {
                const bf16* qp = Q + (size_t)(t0 + 32 + al) * D + h * 64 + 8 * hi;
#pragma unroll
                for (int s = 0; s < 4; ++s) qr[s] = *(const bf16x8*)(qp + 16 * s);
            }
            float mx = sink2;
#pragma unroll
            for (int jj = 0; jj < 5; ++jj) {
#pragma unroll
                for (int r = 0; r < 16; ++r) {
                    const int kr = crow(r, hi), dist = 128 - 32 * jj + al - kr, b = 32 * (i + jj) + kr;
                    const bool inband = (jj >= 1 && jj <= 3) ? true : (dist >= 0 && dist < WIN);
                    const bool valid = inband && (qb > 0 || b >= 128);
                    const float v = valid ? S[jj][r] + bt[dist & (WIN - 1)] : -INFINITY;
                    S[jj][r] = v; mx = fmaxf(mx, v);
                }
                asm volatile("" ::: "memory");
            }
            mx = fmaxf(mx, __shfl_xor(mx, 32));
            float l = 0.f;
            v4u P[5][2];
#pragma unroll
            for (int jj = 0; jj < 5; ++jj)
#pragma unroll
                for (int ks = 0; ks < 2; ++ks)
#pragma unroll
                    for (int e = 0; e < 4; ++e) {
                        const float p0 = __builtin_amdgcn_exp2f(S[jj][8 * ks + 2 * e] - mx), p1 = __builtin_amdgcn_exp2f(S[jj][8 * ks + 2 * e + 1] - mx);
                        l += p0 + p1; P[jj][ks][e] = pg8::cvt_pk_bf16(p0, p1);
                    }
            l += __shfl_xor(l, 32);
            l += __builtin_amdgcn_exp2f(sink2 - mx);
            const float inv = 1.0f / l;
            v4u zz[2][2];
#pragma unroll
            for (int ps = 0; ps < 2; ++ps) { const v4u* zp = (const v4u*)(Z + (size_t)(t0 + (lane >> 2) + 16 * ps) * D + h * 64 + (lane & 3) * 16); zz[ps][0] = zp[0]; zz[ps][1] = zp[1]; }
            f32x16 o[2];
            o[0] = (f32x16){0.f, 0.f, 0.f, 0.f, 0.f, 0.f, 0.f, 0.f, 0.f, 0.f, 0.f, 0.f, 0.f, 0.f, 0.f, 0.f}; o[1] = o[0];
#pragma unroll
            for (int jj = 0; jj < 5; ++jj)
#pragma unroll
                for (int ks = 0; ks < 2; ++ks) {
                    const bf16x8 pf = __builtin_bit_cast(bf16x8, P[jj][ks]);
                    const int kb = 32 * (i + jj) + 16 * ks + 4 * hi;
#pragma unroll
                    for (int db = 0; db < 2; ++db) {
                        const LAS unsigned char* vp = lds + LDS_V + (32 * db + al) * VP + kb * 2;
                        const v2u lo = *(const LAS v2u*)vp, hh = *(const LAS v2u*)(vp + 16);
                        const v4u vw = {lo.x, lo.y, hh.x, hh.y};
                        o[db] = __builtin_amdgcn_mfma_f32_32x32x16_bf16(__builtin_bit_cast(bf16x8, vw), pf, o[db], 0, 0, 0);
                    }
                }
#pragma unroll
            for (int db = 0; db < 2; ++db)
#pragma unroll
                for (int rq = 0; rq < 4; ++rq) {
                    v2u w; w.x = pg8::cvt_pk_bf16(o[db][4 * rq] * inv, o[db][4 * rq + 1] * inv); w.y = pg8::cvt_pk_bf16(o[db][4 * rq + 2] * inv, o[db][4 * rq + 3] * inv);
                    *(LAS v2u*)(st + al * SP + (32 * db + 8 * rq + 4 * hi) * 2) = w;
                }
            LDS_WAIT(); asm volatile("" ::: "memory");
#pragma unroll
            for (int ps = 0; ps < 2; ++ps) {
                const int row = (lane >> 2) + 16 * ps, c16 = (lane & 3) * 16;
                const v4u oa = *(const LAS v4u*)(st + row * SP + c16 * 2), ob = *(const LAS v4u*)(st + row * SP + c16 * 2 + 16);
                float y[16];
#pragma unroll
                for (int e = 0; e < 4; ++e) { y[2 * e] = bflo(oa[e]) * bflo(zz[ps][0][e]) * AG_SCALE; y[2 * e + 1] = bfhi(oa[e]) * bfhi(zz[ps][0][e]) * AG_SCALE;
                                              y[8 + 2 * e] = bflo(ob[e]) * bflo(zz[ps][1][e]) * AG_SCALE; y[8 + 2 * e + 1] = bfhi(ob[e]) * bfhi(zz[ps][1][e]) * AG_SCALE; }
                if (USE_FP8_B >= 2) {
                    v4u w;
#pragma unroll
                    for (int e = 0; e < 4; ++e) w[e] = pk4_fp8(y[4 * e], y[4 * e + 1], y[4 * e + 2], y[4 * e + 3]);
                    *(v4u*)((unsigned char*)Ov + (size_t)(t0 + row) * D + h * 64 + c16) = w;
                } else {
                    v4u w0, w1;
#pragma unroll
                    for (int e = 0; e < 4; ++e) { w0[e] = pk2(y[2 * e], y[2 * e + 1]); w1[e] = pk2(y[8 + 2 * e], y[8 + 2 * e + 1]); }
                    v4u* op = (v4u*)((bf16*)Ov + (size_t)(t0 + row) * D + h * 64 + c16); op[0] = w0; op[1] = w1;
                }
            }
            LDS_WAIT(); asm volatile("" ::: "memory");
        }
    }
}
}

__device__ __forceinline__ void final_norm(float* X, const LAS float* G, int gw, int NGW, int lane) {
    for (int m = gw; m < M; m += NGW) {
        asm volatile("" ::: "memory");
        f32x4* xr = (f32x4*)(X + (size_t)m * D) + lane;
        f32x4 v[16]; float s = 0.f;
#pragma unroll
        for (int j = 0; j < 16; ++j) { v[j] = xr[64 * j]; s += (v[j][0] * v[j][0] + v[j][1] * v[j][1]) + (v[j][2] * v[j][2] + v[j][3] * v[j][3]); }
        const float rstd = __builtin_amdgcn_rsqf(wave_sum(s) * (1.f / D) + EPS);
#pragma unroll
        for (int j = 0; j < 16; ++j) xr[64 * j] = v[j] * rstd * *(const LAS f32x4*)(G + 256 * j + 4 * lane);
    }
}

struct Args { const float* in[20]; float* out; unsigned char* ws; int ph_lo, ph_hi; };
static_assert(sizeof(Args) == 22 * 8 + 8, "Args has no padding");
__global__ void __launch_bounds__(NWAVES * 64, 2) mk_fwd(Args args) {
    extern __shared__ __attribute__((aligned(16))) unsigned char lds_raw[];
    LAS unsigned char* lds = (LAS unsigned char*)lds_raw;
    volatile LAS unsigned* MISC = (volatile LAS unsigned*)(lds + MISC_OFF);
    const int tid = threadIdx.x, lane = tid & 63, wave = __builtin_amdgcn_readfirstlane(tid >> 6);
    const int G = gridDim.x; const int bx = blockIdx.x; const int vcu = (G % 8 == 0) ? (bx % 8) * (G / 8) + bx / 8 : bx;
    const int gw = vcu * NWAVES + wave, NGW = G * NWAVES, gtid = bx * (NWAVES * 64) + tid, gtotal = G * NWAVES * 64;
    unsigned char* ws = args.ws;
    gu32* ctl = (gu32*)(ws + WS_CTL);
    const float* x = args.in[0]; const float* cvec = args.in[1]; const float* g_a = args.in[2]; const float* w_mod_a = args.in[3]; const float* b_mod_a = args.in[4];
    const float* w_a_in = args.in[5]; const float* conv_a = args.in[6]; const float* w_a_out = args.in[7]; const float* g_kv = args.in[8]; const float* w_mod_kv = args.in[9];
    const float* b_mod_kv = args.in[10]; const float* w_kv = args.in[11]; const float* rel_bias = args.in[12]; const float* g_b = args.in[13]; const float* w_mod_b = args.in[14];
    const float* b_mod_b = args.in[15]; const float* w_b_in = args.in[16]; const float* sinks_b = args.in[17]; const float* w_b_out = args.in[18]; const float* g_final = args.in[19];
    float* out = args.out;
    float* modp = (float*)(ws + WS_MODP); float* modv = (float*)(ws + WS_MODV);
    bf16* W_AIN = (bf16*)(ws + WS_WAIN); bf16* W_AOUT = (bf16*)(ws + WS_WAOUT); bf16* W_KV = (bf16*)(ws + WS_WKV); bf16* W_BIN = (bf16*)(ws + WS_WBIN); bf16* W_BOUT = (bf16*)(ws + WS_WBOUT);
    bf16* HA = (bf16*)(ws + WS_HA); bf16* YB = (bf16*)(ws + WS_Y); float* X1 = (float*)(ws + WS_X1); bf16* PROJ = (bf16*)(ws + WS_BIG);
    float* CUH = (float*)(ws + WS_HALO); float* BSH = (float*)(ws + WS_HALO + 2 * MiB); float* PCH = (float*)(ws + WS_HALO + 4 * MiB);
    bf16* QB = (bf16*)(ws + WS_Q); bf16* ZB = (bf16*)(ws + WS_Z); bf16* AG = (bf16*)(ws + WS_AG); bf16* KB = (bf16*)(ws + WS_K); bf16* VB = (bf16*)(ws + WS_V);

    for (int u = tid; u < (LDS_BYTES - LDSCTL_OFF) / 4; u += NWAVES * 64) ((LAS unsigned*)(lds + LDSCTL_OFF))[u] = 0u;
    __syncthreads();
    XcdBarrier bar; bar.bar = (unsigned*)(ctl + CW_BAR); bar.x = 0; bar.st = nullptr;
    if (N_LAUNCHES == 1) bar = xcd_barrier_post((unsigned*)(ctl + CW_BAR), MISC + 8);
#define GRID_BAR(seam) do { if (N_LAUNCHES != 1) { if (tid == 0) __hip_atomic_store(ctl + CW_TMO, 0xBADBA0u | (unsigned)(seam), RLX_AGENT); } else { xcd_barrier(bar); } } while (0)
    const int lo = args.ph_lo, hi = args.ph_hi;
#define IN(k) (lo <= (k) && (k) < hi)
#define PH_ON(k) (ONLY_PHASE < 0 || ONLY_PHASE == (k))
#define BOTH(k) (IN(k) && IN((k) + 1))

    if (PH_ON(0) && IN(0)) {
        p0_gemv(lds, cvec, w_mod_a, w_mod_kv, w_mod_b, modp, vcu, G, tid, lane, wave);
        LAS unsigned short* T = (LAS unsigned short*)(lds + wave * 9216);
        constexpr int I_AIN = 64 * 256, I_AOUT = 64 * 64, I_KV = 64 * 16, I_BIN = 64 * 128, I_BOUT = 64 * 64, NITEMS = I_AIN + I_AOUT + I_KV + I_BIN + I_BOUT;
        for (int it = gw; it < NITEMS * REP_P0; it += NGW) {
            int r = it % NITEMS;
            if (r < I_AIN) { p0_transpose_item<USE_FUSED_CONV>(w_a_in, 16384, W_AIN, T, r, lane); continue; } r -= I_AIN;
            if (r < I_AOUT) { p0_transpose_item<0>(w_a_out, 4096, W_AOUT, T, r, lane); continue; } r -= I_AOUT;
#if USE_FP8_B >= 1
            if (r < I_KV) { p0_transpose_item_fp8(w_kv, 1024, (unsigned char*)W_KV, (LAS unsigned char*)T, r, lane); continue; } r -= I_KV;
            if (r < I_BIN) { p0_transpose_item_fp8(w_b_in, 8192, (unsigned char*)W_BIN, (LAS unsigned char*)T, r, lane); continue; } r -= I_BIN;
#else
            if (r < I_KV) { p0_transpose_item<0>(w_kv, 1024, W_KV, T, r, lane); continue; } r -= I_KV;
            if (r < I_BIN) { p0_transpose_item<0>(w_b_in, 8192, W_BIN, T, r, lane); continue; } r -= I_BIN;
#endif
#if USE_FP8_B >= 2
            p0_transpose_item_fp8(w_b_out, 4096, (unsigned char*)W_BOUT, (LAS unsigned char*)T, r, lane);
#else
            p0_transpose_item<0>(w_b_out, 4096, W_BOUT, T, r, lane);
#endif
        }
        if (BOTH(0)) GRID_BAR(0);
    }
    if (PH_ON(1) && IN(1)) {
        LAS float* GS = (LAS float*)lds;
        for (int i = tid; i < D; i += NWAVES * 64) {
            const float sh = b_mod_a[i] + modp[MOD_A + i] + modp[NMOD + MOD_A + i];
            const float sc = b_mod_a[D + i] + modp[MOD_A + D + i] + modp[NMOD + MOD_A + D + i];
            GS[i] = g_a[i] * (1.0f + sc); GS[D + i] = sh; }
        for (int n = gtid; n < NMOD; n += gtotal) modv[n] = bcat(b_mod_a, b_mod_kv, b_mod_b, n) + modp[n] + modp[NMOD + n];
        __syncthreads();
        norm_rows_bf16<1>(x, HA, nullptr, GS, gw, NGW, lane);
        __syncthreads();
        if (BOTH(1)) GRID_BAR(1);
    }
    if (PH_ON(2) && IN(2)) {
        pg8::Gemm g{HA, W_AIN, M, 4 * D, D}; pg8::RepOrder S; S.init(M, 4 * D, G, bx); S.rep = REP_P2;
#if USE_FUSED_CONV
        pg8::EpiConvGate E{YB, conv_a, CUH, BSH, PCH, (LAS float*)(lds + XCH_OFF)};
        pg8::gemm_phase<pg8::EpiConvGate, pg8::RepOrder, true, true>(lds + RING_OFF, g, S, E);
#else
        pg8::EpiBf16S E{PROJ, 4 * D, 0, 0, 1.f, 0, 1.f};
        pg8::gemm_phase<pg8::EpiBf16S, pg8::RepOrder, true, true>(lds + RING_OFF, g, S, E);
#endif
        if (BOTH(2)) GRID_BAR(2);
    }
    if (PH_ON(3) && IN(3)) {
#if USE_FUSED_CONV
        conv_fixup(BSH, PCH, CUH, conv_a, YB, gtid, gtotal);
#else
        convgate_naive(PROJ, conv_a, YB, gtid, gtotal);
#endif
        if (BOTH(3)) GRID_BAR(3);
    }
    if (PH_ON(4) && IN(4)) {
        pg8::Gemm g{YB, W_AOUT, M, D, D}; pg8::StaticOrder S; S.init(M, D, G, bx);
        pg8::EpiResGate E{x, X1, D, modv + MOD_A + 2 * D, 1.f};
        pg8::gemm_phase<pg8::EpiResGate, pg8::StaticOrder, true, true>(lds + RING_OFF, g, S, E);
        if (BOTH(4)) GRID_BAR(4);
    }
    if (PH_ON(5) && IN(5)) {
        LAS float* GS = (LAS float*)lds;
        for (int i = tid; i < D; i += NWAVES * 64) {
            GS[i] = g_kv[i] * (1.0f + modv[MOD_KV + D + i]); GS[D + i] = modv[MOD_KV + i];
            GS[2 * D + i] = g_b[i] * (1.0f + modv[MOD_B + D + i]); GS[3 * D + i] = modv[MOD_B + i]; }
        __syncthreads();
#if USE_FP8_B >= 1
        norm_rows_fp8<2>(X1, (unsigned char*)HA, (unsigned char*)YB, GS, gw, NGW, lane);
#else
        norm_rows_bf16<2>(X1, HA, YB, GS, gw, NGW, lane);
#endif
        __syncthreads();
        if (BOTH(5)) GRID_BAR(5);
    }
    if (PH_ON(6) && IN(6)) {
        constexpr bool F8 = (USE_FP8_B >= 1); constexpr int KK = F8 ? D / 2 : D; constexpr float PRE = F8 ? W8_INV : 1.0f;
        { pg8::Gemm g{HA, W_KV, M, 2 * KVD, KK}; pg8::StaticOrder S; S.init(M, 2 * KVD, G, bx);
          pg8::EpiBf16S E{KB, KVD, KVD, (size_t)(WS_V - WS_K) / 2, 1.f, 0, PRE};
          pg8::gemm_phase<pg8::EpiBf16S, pg8::StaticOrder, true, true, F8>(lds + RING_OFF, g, S, E); }
        { pg8::Gemm g{YB, W_BIN, M, 2 * D, KK}; pg8::StaticOrder S; S.init(M, 2 * D, G, bx);
          pg8::EpiBf16S E{QB, D, D, (size_t)(WS_Z - WS_Q) / 2, QSCALE, 1, PRE};
          pg8::gemm_phase<pg8::EpiBf16S, pg8::StaticOrder, true, true, F8>(lds + RING_OFF, g, S, E); }
        if (BOTH(6)) GRID_BAR(6);
    }
    if (PH_ON(7) && IN(7)) {
#if USE_MFMA_ATTN
        swa::attn_phase(lds, QB, KB, VB, ZB, AG, rel_bias, sinks_b, vcu, G, tid, lane, wave);
#else
        attn_naive(lds, QB, KB, VB, ZB, AG, rel_bias, sinks_b, gtid, gtotal, tid);
#endif
        __syncthreads();
        if (BOTH(7)) GRID_BAR(7);
    }
    if (PH_ON(8) && IN(8)) {
        constexpr bool F8 = (USE_FP8_B >= 2); constexpr int KK = F8 ? D / 2 : D; constexpr float GM = F8 ? W8_INV / swa::AG_SCALE : 1.0f;
        pg8::Gemm g{AG, W_BOUT, M, D, KK}; pg8::StaticOrder S; S.init(M, D, G, bx);
        pg8::EpiResGate E{X1, out, D, modv + MOD_B + 2 * D, GM};
        pg8::gemm_phase<pg8::EpiResGate, pg8::StaticOrder, true, true, F8>(lds + RING_OFF, g, S, E);
        if (BOTH(8)) GRID_BAR(8);
    }
    if (PH_ON(9) && IN(9)) {
        LAS float* GF = (LAS float*)lds;
        for (int i = tid; i < D; i += NWAVES * 64) GF[i] = g_final[i];
        __syncthreads();
        final_norm(out, GF, gw, NGW, lane);
    }
#undef IN
#undef BOTH
}

extern "C" void kernel_launch(void* const* d_in, const int* in_sizes, int n_in, void* d_out, int out_size, void* d_ws, size_t ws_size, hipStream_t stream) {
    static int grid = 0;
    if (grid == 0) {
        if (n_in != 20 || in_sizes[0] != M * D || out_size != M * D || ws_size < WS_END) { fprintf(stderr, "kernel_launch: built for 20 inputs, x/out of %d floats, >= %zu bytes of workspace; got n_in %d, in0 %d, out %d, ws %zu; nothing launched\n", M * D, (size_t)WS_END, n_in, n_in > 0 ? in_sizes[0] : -1, out_size, ws_size); grid = -1; return; }
        int dev = 0, cus = 0, per_cu = 0;
        if (hipGetDevice(&dev) != hipSuccess || hipDeviceGetAttribute(&cus, hipDeviceAttributeMultiprocessorCount, dev) != hipSuccess) { fprintf(stderr, "kernel_launch: hipGetDevice / hipDeviceGetAttribute failed\n"); grid = -1; return; }
        if (hipFuncSetAttribute((const void*)mk_fwd, hipFuncAttributeMaxDynamicSharedMemorySize, LDS_BYTES) != hipSuccess) { fprintf(stderr, "kernel_launch: hipFuncSetAttribute failed\n"); grid = -1; return; }
        if (hipOccupancyMaxActiveBlocksPerMultiprocessor(&per_cu, (const void*)mk_fwd, NWAVES * 64, LDS_BYTES) != hipSuccess || per_cu < 1)
            fprintf(stderr, "kernel_launch: note: the occupancy query reports %d workgroups per CU\n", per_cu);
        (void)hipGetLastError();
        grid = cus;
    }
    if (grid < 0) return;
    if (hipMemsetAsync((char*)d_ws + WS_CTL, 0, CTL_ZERO_BYTES, stream) != hipSuccess) { fprintf(stderr, "kernel_launch: hipMemsetAsync failed\n"); return; }
    Args a{};
    for (int i = 0; i < 20; ++i) a.in[i] = (const float*)d_in[i];
    a.out = (float*)d_out; a.ws = (unsigned char*)d_ws;
    for (int li = 0; li < N_LAUNCHES; ++li) {
        a.ph_lo = (N_LAUNCHES == 1) ? 0 : li; a.ph_hi = (N_LAUNCHES == 1) ? NPH : li + 1;
        hipLaunchKernelGGL(mk_fwd, dim3(grid), dim3(NWAVES * 64), LDS_BYTES, stream, a);
        const hipError_t le = hipPeekAtLastError();
        if (le != hipSuccess) { fprintf(stderr, "kernel_launch: launch %d failed: %s\n", li, hipGetErrorName(le)); break; }
    }
}
```
